# Optimizing an MI355X kernel written in HIP

```python
import math
import jax, jax.numpy as jnp
from jax import lax
import numpy as np

D_MODEL = 1024
BATCH = 8
SEQ = 2048
DEPTH = 4
DEC_BATCH = 128
DEC_SEQ = 4
PAST_LEN = 16384
PAGE_SIZE = 128

N_MIXERS = 2
BRANCH = D_MODEL
HEAD_DIM = 128
N_HEADS = BRANCH // HEAD_DIM
HEAD_DK = HEAD_DIM
HEAD_DV = HEAD_DIM
CONV_W = 3
HGRN_CHUNK = 64
N_CONV_LAYERS = (DEPTH + 1) // 2
N_HGRN_LAYERS = DEPTH // 2
RMS_EPS = 1e-6
LOG_F_FLOOR = -20.0

kernel_name = "hybrid_shortconv_hgrn2_decode_step"


def rms_norm(x, g):
    xf = x.astype(jnp.float32)
    y = xf * lax.rsqrt(jnp.mean(xf * xf, axis=-1, keepdims=True) + RMS_EPS)
    return (y * g.astype(jnp.float32)).astype(x.dtype)


def conv_branch(h, w_in, w_conv, w_out, buf):
    T = h.shape[1]
    proj = h @ w_in
    v, bg, cg, z = jnp.split(proj, 4, axis=-1)
    u = cg * v
    u_ext = jnp.concatenate([buf.astype(u.dtype), u], axis=1)
    conv = w_conv[0] * u_ext[:, 0:T]
    for j in range(1, CONV_W):
        conv = conv + w_conv[j] * u_ext[:, j:j + T]
    new_buf = u_ext[:, -(CONV_W - 1):]
    y = (bg * conv * jax.nn.silu(z)) @ w_out
    return y, new_buf


def hgrn2_chunked(q, k, v, log_f, s0):
    b, T = q.shape[:2]
    C = math.gcd(T, HGRN_CHUNK)
    nc = T // C

    def to_chunks(a):
        return a.reshape(b, nc, C, a.shape[2], a.shape[3]).transpose(1, 0, 3, 2, 4)

    mask = jnp.tril(jnp.ones((C, C), dtype=bool))[None, None, :, :, None]

    def step(S, inp):
        qc, kc, vc, gc = inp
        bcum = jnp.cumsum(gc, axis=2)
        rel = jnp.where(mask, bcum[:, :, :, None, :] - bcum[:, :, None, :, :], -jnp.inf)
        A = jnp.einsum('bhtk,bhtsk,bhsk->bhts', qc, jnp.exp(rel), kc)
        o = jnp.einsum('bhts,bhsv->bhtv', A, vc) + jnp.einsum('bhtk,bhkv->bhtv', qc * jnp.exp(bcum), S)
        b_last = bcum[:, :, -1:, :]
        S = jnp.exp(b_last[:, :, 0, :])[..., None] * S + jnp.einsum(
            'bhsk,bhsv->bhkv', kc * jnp.exp(b_last - bcum), vc)
        return S, o

    S, o = lax.scan(step, s0, (to_chunks(q), to_chunks(k), to_chunks(v), to_chunks(log_f)))
    o = o.transpose(1, 0, 3, 2, 4).reshape(b, T, q.shape[2], v.shape[-1])
    return o, S


def hgrn_branch(h, w_in, lb, g_onorm, w_out, s0):
    b, T = h.shape[:2]
    proj = h @ w_in
    q, fpre, inp, z = jnp.split(proj, 4, axis=-1)
    shp = (b, T, N_HEADS, HEAD_DK)
    q = jax.nn.silu(q.astype(jnp.float32)).reshape(shp) * (HEAD_DK ** -0.5)
    fpre = fpre.astype(jnp.float32).reshape(shp)
    vv = inp.astype(jnp.float32).reshape(b, T, N_HEADS, HEAD_DV)
    lb = lb.reshape(N_HEADS, HEAD_DK)
    log_f = jnp.logaddexp(jnp.log(lb), jnp.log1p(-lb) + jax.nn.log_sigmoid(fpre))
    log_f = jnp.maximum(log_f, LOG_F_FLOOR)
    k = -jnp.expm1(log_f)
    o, S = hgrn2_chunked(q, k, vv, log_f, s0)
    o = rms_norm(o, g_onorm).reshape(b, T, BRANCH).astype(h.dtype)
    y = (o * jax.nn.silu(z)) @ w_out
    return y, S


def setup_inputs(seed: int = 0) -> dict:
    key = jax.random.key(seed)
    ks = jax.random.split(key, 11)
    E = BRANCH
    return {
        "x_prompt": jax.random.normal(ks[0], (BATCH, SEQ, D_MODEL), jnp.float32),
        "x_sample": jax.random.normal(ks[1], (DEC_BATCH, DEC_SEQ, D_MODEL), jnp.float32),
        "state_conv": jax.random.normal(ks[2], (N_CONV_LAYERS, DEC_BATCH, CONV_W - 1, E), jnp.float32),
        "state_hgrn": 0.5 * jax.random.normal(ks[3], (N_HGRN_LAYERS, DEC_BATCH, N_HEADS, HEAD_DK, HEAD_DV), jnp.float32),
        "norm_pre": 1.0 + 0.05 * jax.random.normal(ks[4], (DEPTH, D_MODEL), jnp.float32),
        "w_in": jax.random.normal(ks[5], (DEPTH, D_MODEL, 4 * E), jnp.float32) * D_MODEL ** -0.5,
        "conv_w": jax.random.normal(ks[6], (N_CONV_LAYERS, CONV_W, E), jnp.float32) * CONV_W ** -0.5,
        "hgrn_lb_logits": 0.5 * jax.random.normal(ks[7], (N_HGRN_LAYERS, E), jnp.float32),
        "hgrn_onorm": 1.0 + 0.05 * jax.random.normal(ks[8], (N_HGRN_LAYERS, HEAD_DV), jnp.float32),
        "w_out": jax.random.normal(ks[9], (DEPTH, E, D_MODEL), jnp.float32) * E ** -0.5,
        "norm_post": 1.0 + 0.05 * jax.random.normal(ks[10], (DEPTH, D_MODEL), jnp.float32),
    }


def reference(x_prompt, x_sample, state_conv, state_hgrn, norm_pre, w_in, conv_w,
              hgrn_lb_logits, hgrn_onorm, w_out, norm_post):
    lb_all = jnp.cumsum(jax.nn.softmax(hgrn_lb_logits.astype(jnp.float32), axis=0), axis=0)
    lb_all = lb_all - lb_all[0:1]

    xp, xs = x_prompt, x_sample
    conv_p, conv_s, hgrn_p, hgrn_s = [], [], [], []
    for i in range(DEPTH):
        j = i // N_MIXERS
        hp = rms_norm(xp, norm_pre[i])
        hs = rms_norm(xs, norm_pre[i])
        if i % N_MIXERS == 0:
            buf0 = jnp.zeros((xp.shape[0], CONV_W - 1, BRANCH), xp.dtype)
            yp, bp = conv_branch(hp, w_in[i], conv_w[j], w_out[i], buf0)
            ys, bs = conv_branch(hs, w_in[i], conv_w[j], w_out[i], state_conv[j])
            conv_p.append(bp.astype(xp.dtype))
            conv_s.append(bs.astype(state_conv.dtype))
        else:
            s0 = jnp.zeros((xp.shape[0], N_HEADS, HEAD_DK, HEAD_DV), jnp.float32)
            yp, Sp = hgrn_branch(hp, w_in[i], lb_all[j], hgrn_onorm[j], w_out[i], s0)
            ys, Ss = hgrn_branch(hs, w_in[i], lb_all[j], hgrn_onorm[j], w_out[i],
                                 state_hgrn[j].astype(jnp.float32))
            hgrn_p.append(Sp.astype(xp.dtype))
            hgrn_s.append(Ss.astype(state_hgrn.dtype))
        xp = xp + rms_norm(yp, norm_post[i])
        xs = xs + rms_norm(ys, norm_post[i])

    return (xp, xs, jnp.stack(conv_p), jnp.stack(conv_s), jnp.stack(hgrn_p), jnp.stack(hgrn_s))
```

```cpp
#include <hip/hip_runtime.h>
#include <cstdio>
#include <cstdint>
namespace pg8 {
#define PG8_LAS __attribute__((address_space(3)))
typedef unsigned short bf16_t;
typedef short bf16x8 __attribute__((ext_vector_type(8)));
typedef float f32x4 __attribute__((ext_vector_type(4)));
typedef unsigned u32x4 __attribute__((ext_vector_type(4)));
constexpr int BM = 256, BK = 64, HALF = 128, HTB = HALF * BK * 2  , STAGE_BYTES = 8 * HTB, NXCD = 8, WGM = 8;

__host__ __device__ __forceinline__ int lds_byte(int r, int c) { const int st = (r >> 4) * 2 + (c >> 5), rr = r & 15, cc = c & 31, ob = rr * 64 + cc * 2; return st * 1024 + (ob ^ (((ob >> 9) & 1) << 5)); }
__host__ __device__ __forceinline__ void stage_rc(int b, int& R, int& C) { const int st = b / 1024, sb = b % 1024, swz = sb ^ (((sb >> 9) & 1) << 5); R = (st >> 1) * 16 + swz / 64; C = (st & 1) * 32 + (swz % 64) / 2; }
__host__ __device__ __forceinline__ int perm32(int rho) { const int n = rho >> 4, i = rho & 15; return 8 * (i >> 2) + 4 * n + (i & 3); }

struct Unit { int pm, pn; };
struct Gemm { const bf16_t* A; const bf16_t* Bt; int M, N, K; };

struct StaticOrder {
    int nM, nN, nwg, G, c;
    __host__ __device__ void init(int M, int N, int G_, int c_) { nM = M / BM; nN = N / BM; nwg = nM * nN; G = G_; c = c_; }
    __host__ __device__ bool next(int i, Unit& u) const {
        const long L = (long)i * G + c; if (L >= nwg) return false;
        int wgid = (int)L; { const int q = nwg / NXCD, r = nwg % NXCD, xcd = wgid % NXCD, off = wgid / NXCD; wgid = (xcd < r ? xcd * (q + 1) : r * (q + 1) + (xcd - r) * q) + off; }
        const int nig = WGM * nN, gid = wgid / nig, fm = gid * WGM, gsz = (nM - fm) < WGM ? (nM - fm) : WGM;
        u.pm = fm + ((wgid % nig) % gsz); u.pn = (wgid % nig) / gsz; return true;
    }
    __device__ __forceinline__ void a_ready(const Unit&) const {}
    __device__ __forceinline__ void done(const Unit&) const {}
};

__device__ __forceinline__ unsigned cvt_pk_bf16(float lo, float hi) { unsigned r; asm volatile("v_cvt_pk_bf16_f32 %0, %1, %2" : "=v"(r) : "v"(lo), "v"(hi)); return r; }
typedef float f32x2 __attribute__((ext_vector_type(2)));
typedef unsigned u32x2 __attribute__((ext_vector_type(2)));
__host__ __device__ __forceinline__ int inproj_row(int nsrc) { const int g = nsrc >> 10, cc = nsrc & 1023, pn = cc >> 6, ch = cc & 63; return 256 * pn + 128 * (g >> 1) + 32 * (ch >> 4) + 16 * (g & 1) + (ch & 15); }
__device__ __forceinline__ float fsigmoid(float x) { return 1.0f / (1.0f + __expf(-x)); }

constexpr int ROWS_P = 16384, ROWS_ALL = 16896, DM = 1024;

struct EpiConvIn {
    static constexpr bool PERM = false, AFTER_DRAIN = false;
    const float* rstd; bf16_t* U; bf16_t* P; float* convp; float* convs;
    __device__ __forceinline__ void operator()(const f32x4 (&acc)[2][2][4][2], const Unit& u, int wr, int wc, int fr, int fq) const {
        const int ch0 = u.pn * 64 + wc * 16 + fq * 4;
#pragma unroll
        for (int ai = 0; ai < 2; ++ai)
#pragma unroll
            for (int m = 0; m < 4; ++m) {
                const int r = u.pm * BM + ai * HALF + wr * 64 + m * 16 + fr;
                const float rs = rstd[r];
                const f32x4 v = acc[ai][0][m][0] * rs, bg = acc[ai][0][m][1] * rs, cg = acc[ai][1][m][0] * rs, z = acc[ai][1][m][1] * rs;
                const f32x4 uu = cg * v; f32x4 pp;
#pragma unroll
                for (int j = 0; j < 4; ++j) pp[j] = bg[j] * z[j] * fsigmoid(z[j]);
                u32x2 wu, wp; wu.x = cvt_pk_bf16(uu[0], uu[1]); wu.y = cvt_pk_bf16(uu[2], uu[3]); wp.x = cvt_pk_bf16(pp[0], pp[1]); wp.y = cvt_pk_bf16(pp[2], pp[3]);
                *(u32x2*)(U + (size_t)r * DM + ch0) = wu; *(u32x2*)(P + (size_t)r * DM + ch0) = wp;
                if (r < ROWS_P) { const int t = r & 2047; if (t >= 2046) *(f32x4*)(convp + ((size_t)(r >> 11) * 2 + (t - 2046)) * DM + ch0) = uu; }
                else { const int rs2 = r - ROWS_P, t = rs2 & 3; if (t >= 2) *(f32x4*)(convs + ((size_t)(rs2 >> 2) * 2 + (t - 2)) * DM + ch0) = uu; }
            }
    }
};
struct EpiHgrnIn {
    static constexpr bool PERM = false, AFTER_DRAIN = false;
    const float* rstd; const float* lb; bf16_t* Q; bf16_t* KK; bf16_t* V; bf16_t* SZ; float* LOGF;
    __device__ __forceinline__ void operator()(const f32x4 (&acc)[2][2][4][2], const Unit& u, int wr, int wc, int fr, int fq) const {
        const int ch0 = u.pn * 64 + wc * 16 + fq * 4;
        const f32x4 lbv = *(const f32x4*)(lb + ch0);
#pragma unroll
        for (int ai = 0; ai < 2; ++ai)
#pragma unroll
            for (int m = 0; m < 4; ++m) {
                const int r = u.pm * BM + ai * HALF + wr * 64 + m * 16 + fr;
                const float rs = rstd[r];
                const f32x4 qr = acc[ai][0][m][0] * rs, fp = acc[ai][0][m][1] * rs, iv = acc[ai][1][m][0] * rs, z = acc[ai][1][m][1] * rs;
                f32x4 q, lf, kk, sz;
#pragma unroll
                for (int j = 0; j < 4; ++j) {
                    q[j] = qr[j] * fsigmoid(qr[j]) * 0.08838834764831845f;
                    const float e = __expf(-fabsf(fp[j])), r1 = 1.0f / (1.0f + e), r2 = e * r1, sg = fp[j] >= 0.f ? r1 : r2, nsg = fp[j] >= 0.f ? r2 : r1;
                    const float f = lbv[j] + (1.0f - lbv[j]) * sg;
                    float l = __logf(f), kv = (1.0f - lbv[j]) * nsg;
                    if (!(l >= -20.0f)) { l = -20.0f; kv = 1.0f - 2.0611536e-9f; }
                    lf[j] = l; kk[j] = kv; sz[j] = z[j] * fsigmoid(z[j]);
                }
                const size_t o = (size_t)r * DM + ch0;
                u32x2 w; w.x = cvt_pk_bf16(q[0], q[1]); w.y = cvt_pk_bf16(q[2], q[3]); *(u32x2*)(Q + o) = w;
                w.x = cvt_pk_bf16(kk[0], kk[1]); w.y = cvt_pk_bf16(kk[2], kk[3]); *(u32x2*)(KK + o) = w;
                w.x = cvt_pk_bf16(iv[0], iv[1]); w.y = cvt_pk_bf16(iv[2], iv[3]); *(u32x2*)(V + o) = w;
                w.x = cvt_pk_bf16(sz[0], sz[1]); w.y = cvt_pk_bf16(sz[2], sz[3]); *(u32x2*)(SZ + o) = w;
                *(f32x4*)(LOGF + o) = lf;
            }
    }
};
struct EpiF32 {
    static constexpr bool PERM = false, AFTER_DRAIN = false;
    float* Y;
    __device__ __forceinline__ void operator()(const f32x4 (&acc)[2][2][4][2], const Unit& u, int wr, int wc, int fr, int fq) const {
#pragma unroll
        for (int ai = 0; ai < 2; ++ai)
#pragma unroll
            for (int m = 0; m < 4; ++m) {
                float* rowp = Y + (size_t)(u.pm * BM + ai * HALF + wr * 64 + m * 16 + fr) * DM + u.pn * BM + wc * 32 + 4 * fq;
#pragma unroll
                for (int bj = 0; bj < 2; ++bj)
#pragma unroll
                    for (int n = 0; n < 2; ++n) *(f32x4*)(rowp + bj * HALF + n * 16) = acc[ai][bj][m][n];
            }
    }
};

template <class Epi, class Sched, bool ALIGN_EPI = false, bool SP2 = false>
__device__ __forceinline__ void gemm_phase(PG8_LAS unsigned char* lds, const Gemm g, const Sched& S, const Epi& E) {
    const int tid = threadIdx.x, wid = __builtin_amdgcn_readfirstlane(tid >> 6), lane = tid & 63, wr = wid >> 2, wc = wid & 3, fr = lane & 15, fq = lane >> 4;
    const int K = g.K, nt = K / BK;
    unsigned voffA[2], voffB[2];
#pragma unroll
    for (int i = 0; i < 2; ++i) { int R, C; stage_rc(tid * 16 + i * 8192, R, C); const int Rb = Epi::PERM ? ((R & ~31) + perm32(R & 31)) : R;
        voffA[i] = (unsigned)(R * K + C) * 2u; voffB[i] = (unsigned)(Rb * K + C) * 2u; }
    const size_t kstep = (size_t)(BK * 2);
    const size_t hstep = (size_t)HALF * K * 2;
    const size_t tstep = 2 * hstep;
    const unsigned ldsw = (unsigned)wid * 1024u;
    const int aoff = lds_byte(wr * 64 + fr, fq * 8), boff = lds_byte(wc * 32 + fr, fq * 8);
#define PG8_SA(b, h) (((b) * 2 + (h)) * HTB)
#define PG8_SB(b, h) ((4 + (b) * 2 + (h)) * HTB)
#define PG8_STAGE(bufoff, gbase, voff) do { _Pragma("unroll") for (int _i = 0; _i < 2; ++_i) \
        __builtin_amdgcn_global_load_lds((const unsigned*)((const char*)(gbase) + (voff)[_i]), (PG8_LAS unsigned*)(lds + (bufoff) + ldsw + _i * 8192), 16, 0, 0); } while (0)
#define PG8_LDA(dst, b, h) do { _Pragma("unroll") for (int m = 0; m < 4; ++m) _Pragma("unroll") for (int k = 0; k < 2; ++k) dst[m][k] = *(const PG8_LAS bf16x8*)(lds + PG8_SA(b, h) + aoff + m * 2048 + k * 1024); } while (0)
#define PG8_LDB(dst, b, h) do { _Pragma("unroll") for (int n = 0; n < 2; ++n) _Pragma("unroll") for (int k = 0; k < 2; ++k) dst[n][k] = *(const PG8_LAS bf16x8*)(lds + PG8_SB(b, h) + boff + n * 2048 + k * 1024); } while (0)
#define PG8_MMA(ai, bj, At, Bt) do { __builtin_amdgcn_s_setprio(1); _Pragma("unroll") for (int m = 0; m < 4; ++m) _Pragma("unroll") for (int n = 0; n < 2; ++n) _Pragma("unroll") for (int k = 0; k < 2; ++k) \
        acc[ai][bj][m][n] = __builtin_amdgcn_mfma_f32_16x16x32_bf16(Bt[n][k], At[m][k], acc[ai][bj][m][n], 0, 0, 0); __builtin_amdgcn_s_setprio(0); } while (0)
#define PG8_WAIT_V(n) asm volatile("s_waitcnt vmcnt(" #n ")" ::: "memory")
#define PG8_WAIT_L(n) asm volatile("s_waitcnt lgkmcnt(" #n ")" ::: "memory")
#define PG8_BAR __builtin_amdgcn_s_barrier()
#define PG8_SCHED __builtin_amdgcn_sched_barrier(0)
    Unit cur, nxt; int ui = 0;
    if (!S.next(0, cur)) return;
    f32x4 acc[2][2][4][2];
#pragma unroll
    for (int a = 0; a < 2; ++a)
#pragma unroll
        for (int b = 0; b < 2; ++b)
#pragma unroll
            for (int m = 0; m < 4; ++m)
#pragma unroll
                for (int n = 0; n < 2; ++n) acc[a][b][m][n] = (f32x4){0.f, 0.f, 0.f, 0.f};
    bf16x8 At[4][2], B0[2][2], B1[2][2];
    const char* cA = (const char*)g.A + (size_t)cur.pm * tstep; const char* cB = (const char*)g.Bt + (size_t)cur.pn * tstep;
    S.a_ready(cur);
    if constexpr (SP2) {
        PG8_STAGE(PG8_SB(0, 0), cB, voffB); PG8_STAGE(PG8_SB(0, 1), cB + hstep, voffB); PG8_STAGE(PG8_SA(0, 0), cA, voffA); PG8_STAGE(PG8_SA(0, 1), cA + hstep, voffA);
        if (wr == 1) PG8_BAR;
        PG8_WAIT_V(2); PG8_BAR;
        PG8_STAGE(PG8_SB(1, 0), cB + kstep, voffB); PG8_STAGE(PG8_SA(1, 0), cA + kstep, voffA); PG8_STAGE(PG8_SB(1, 1), cB + hstep + kstep, voffB);
        PG8_WAIT_V(6); PG8_BAR;
    } else {
        PG8_STAGE(PG8_SB(0, 0), cB, voffB); PG8_STAGE(PG8_SA(0, 0), cA, voffA); PG8_STAGE(PG8_SB(0, 1), cB + hstep, voffB); PG8_STAGE(PG8_SA(0, 1), cA + hstep, voffA);
        if (wr == 1) PG8_BAR;
        PG8_WAIT_V(4); PG8_BAR;
        PG8_STAGE(PG8_SB(1, 0), cB + kstep, voffB); PG8_STAGE(PG8_SA(1, 0), cA + kstep, voffA); PG8_STAGE(PG8_SB(1, 1), cB + hstep + kstep, voffB);
        PG8_WAIT_V(6); PG8_BAR;
    }
    for (;;) {
        const bool has_next = S.next(ui + 1, nxt);
        const char* nA = has_next ? (const char*)g.A + (size_t)nxt.pm * tstep : cA; const char* nB = has_next ? (const char*)g.Bt + (size_t)nxt.pn * tstep : cB;
        for (int t = 0; t < nt; t += 2) {
            const bool last = (t == nt - 2);
            const char* a1 = cA + (size_t)(t + 1) * kstep;
            const char* a2 = last ? nA : cA + (size_t)(t + 2) * kstep; const char* b2 = last ? nB : cB + (size_t)(t + 2) * kstep;
            const char* a3 = a2 + kstep; const char* b3 = b2 + kstep;
            if (last && has_next) S.a_ready(nxt);
            if constexpr (SP2) {
            PG8_LDB(B0, 0, 0); PG8_LDB(B1, 0, 1); PG8_SCHED; PG8_LDA(At, 0, 0); PG8_STAGE(PG8_SA(1, 1), a1 + hstep, voffA);
            PG8_WAIT_V(8); PG8_WAIT_L(0); PG8_BAR; PG8_MMA(0, 0, At, B0); PG8_MMA(0, 1, At, B1); PG8_BAR; PG8_SCHED;
            PG8_LDA(At, 0, 1); PG8_STAGE(PG8_SB(0, 0), b2, voffB); PG8_STAGE(PG8_SB(0, 1), b2 + hstep, voffB); PG8_STAGE(PG8_SA(0, 0), a2, voffA);
            PG8_WAIT_V(8); PG8_WAIT_L(0); PG8_BAR; PG8_MMA(1, 0, At, B0); PG8_MMA(1, 1, At, B1); PG8_BAR; PG8_SCHED;
            PG8_LDB(B0, 1, 0); PG8_LDB(B1, 1, 1); PG8_SCHED; PG8_LDA(At, 1, 0); PG8_STAGE(PG8_SA(0, 1), a2 + hstep, voffA);
            PG8_WAIT_V(8); PG8_WAIT_L(0); PG8_BAR; PG8_MMA(0, 0, At, B0); PG8_MMA(0, 1, At, B1); PG8_BAR; PG8_SCHED;
            PG8_LDA(At, 1, 1); PG8_STAGE(PG8_SB(1, 0), b3, voffB); PG8_STAGE(PG8_SB(1, 1), b3 + hstep, voffB); PG8_STAGE(PG8_SA(1, 0), a3, voffA);
            PG8_WAIT_V(8); PG8_WAIT_L(0); PG8_BAR; PG8_MMA(1, 0, At, B0); PG8_MMA(1, 1, At, B1); PG8_BAR; PG8_SCHED;
            } else {
            PG8_LDB(B0, 0, 0); PG8_SCHED; PG8_LDA(At, 0, 0); PG8_STAGE(PG8_SA(1, 1), a1 + hstep, voffA);
            PG8_WAIT_L(8); PG8_BAR; PG8_WAIT_L(0); PG8_MMA(0, 0, At, B0); PG8_BAR; PG8_SCHED;
            PG8_LDB(B1, 0, 1); PG8_STAGE(PG8_SB(0, 0), b2, voffB);
            PG8_BAR; PG8_WAIT_L(0); PG8_MMA(0, 1, At, B1); PG8_BAR;
            PG8_LDA(At, 0, 1); PG8_STAGE(PG8_SA(0, 0), a2, voffA);
            PG8_BAR; PG8_WAIT_L(0); PG8_MMA(1, 0, At, B0); PG8_BAR; PG8_SCHED;
            PG8_STAGE(PG8_SB(0, 1), b2 + hstep, voffB);
            PG8_WAIT_V(6); PG8_BAR; PG8_MMA(1, 1, At, B1); PG8_BAR;
            PG8_LDB(B0, 1, 0); PG8_SCHED; PG8_LDA(At, 1, 0); PG8_STAGE(PG8_SA(0, 1), a2 + hstep, voffA);
            PG8_WAIT_L(8); PG8_BAR; PG8_WAIT_L(0); PG8_MMA(0, 0, At, B0); PG8_BAR; PG8_SCHED;
            PG8_LDB(B1, 1, 1); PG8_STAGE(PG8_SB(1, 0), b3, voffB);
            PG8_BAR; PG8_WAIT_L(0); PG8_MMA(0, 1, At, B1); PG8_BAR;
            PG8_LDA(At, 1, 1); PG8_STAGE(PG8_SA(1, 0), a3, voffA);
            PG8_BAR; PG8_WAIT_L(0); PG8_MMA(1, 0, At, B0); PG8_BAR; PG8_SCHED;
            PG8_STAGE(PG8_SB(1, 1), b3 + hstep, voffB);
            PG8_WAIT_V(6); PG8_BAR; PG8_MMA(1, 1, At, B1); PG8_BAR;
            }
        }
        if constexpr (ALIGN_EPI) { if (wr == 0) PG8_BAR; }
        if constexpr (!Epi::AFTER_DRAIN) { E(acc, cur, wr, wc, fr, fq); S.done(cur); }
        if (!has_next) break;
#pragma unroll
        for (int a = 0; a < 2; ++a)
#pragma unroll
            for (int b = 0; b < 2; ++b)
#pragma unroll
                for (int m = 0; m < 4; ++m)
#pragma unroll
                    for (int n = 0; n < 2; ++n) acc[a][b][m][n] = (f32x4){0.f, 0.f, 0.f, 0.f};
        cur = nxt; cA = nA; cB = nB; ++ui;
        if constexpr (ALIGN_EPI) { if (wr == 1) PG8_BAR; }
    }
    PG8_WAIT_V(0);
    if constexpr (!ALIGN_EPI) { if (wr == 0) PG8_BAR; }
    PG8_BAR;
    if constexpr (Epi::AFTER_DRAIN) { E.fused(acc, cur, wr, wc, fr, fq, lds, wid, lane); S.done(cur); }
#undef PG8_SA
#undef PG8_SB
#undef PG8_STAGE
#undef PG8_LDA
#undef PG8_LDB
#undef PG8_MMA
#undef PG8_WAIT_V
#undef PG8_WAIT_L
#undef PG8_BAR
#undef PG8_SCHED
}
}

constexpr int NWAVES = 8;
constexpr int BATCH = 8, SEQ = 2048, DEC_BATCH = 128, DEC_SEQ = 4, D = 1024, NPROJ = 4096, DEPTH = 4, NHEAD = 8, HD = 128;
constexpr int MP = BATCH * SEQ;
constexpr int MS = DEC_BATCH * DEC_SEQ;
constexpr int M = MP + MS;
constexpr float RMS_EPS = 1e-6f;
constexpr size_t OUT_Y = 0;
constexpr size_t OUT_CONVP = (size_t)M * D;
constexpr size_t OUT_CONVS = OUT_CONVP + 2 * 8 * 2 * 1024;
constexpr size_t OUT_HP = OUT_CONVS + 2 * 128 * 2 * 1024;
constexpr size_t OUT_HS = OUT_HP + (size_t)2 * 8 * 8 * 128 * 128;
constexpr size_t OUT_END = OUT_HS + (size_t)2 * 128 * 8 * 128 * 128;
constexpr size_t MiB = 1u << 20;
constexpr size_t WS_CTL = 0, CTL_ZERO_BYTES = 1 * MiB;
constexpr size_t WS_MISC = 1 * MiB;
constexpr size_t WS_WIN = 2 * MiB;
constexpr size_t WS_WOUT = 34 * MiB;
constexpr size_t ACT = 33 * MiB;
constexpr size_t WS_XB = 42 * MiB;
constexpr size_t WS_A0 = WS_XB + ACT, WS_A1 = WS_A0 + ACT, WS_A2 = WS_A1 + ACT, WS_A3 = WS_A2 + ACT, WS_A4 = WS_A3 + ACT, WS_A5 = WS_A4 + ACT;
constexpr size_t WS_F0 = WS_A5 + ACT;
constexpr size_t WS_Y = WS_F0 + 2 * ACT;
constexpr size_t WS_END = WS_Y + 2 * ACT;
static_assert((size_t)M * D * 2 <= ACT && WS_END <= 512 * MiB, "d_ws map");
constexpr int CW_BAR = 4096;
constexpr int RING_OFF = 0, RING_BYTES = 131072;
constexpr int LDSCTL_OFF = RING_BYTES, MISC_OFF = LDSCTL_OFF + 320;
constexpr int LDS_BYTES = 147456;

#define GAS __attribute__((address_space(1)))
#define LAS __attribute__((address_space(3)))
typedef unsigned short bf16;
typedef unsigned v4u __attribute__((ext_vector_type(4)));
typedef unsigned v2u __attribute__((ext_vector_type(2)));
typedef float f32x4 __attribute__((ext_vector_type(4)));
typedef short bf16x8 __attribute__((ext_vector_type(8)));
typedef GAS unsigned gu32;
#define RLX_AGENT __ATOMIC_RELAXED, __HIP_MEMORY_SCOPE_AGENT
#define LDS_WAIT() asm volatile("s_waitcnt lgkmcnt(0)" ::: "memory")
#define VM_WAIT() asm volatile("s_waitcnt vmcnt(0)" ::: "memory")
__device__ __forceinline__ unsigned f2bf(float f) { unsigned u = __builtin_bit_cast(unsigned, f); return (u + 0x7fffu + ((u >> 16) & 1u)) >> 16; }
__device__ __forceinline__ unsigned pk2(float lo, float hi) { return f2bf(lo) | (f2bf(hi) << 16); }
__device__ __forceinline__ float bflo(unsigned w) { return __builtin_bit_cast(float, w << 16); }
__device__ __forceinline__ float bfhi(unsigned w) { return __builtin_bit_cast(float, w & 0xffff0000u); }
__device__ __forceinline__ float bf1(bf16 h) { return __builtin_bit_cast(float, (unsigned)h << 16); }

#define XB_TMO      128
#define XB_XCNT(j)  (256  + 64 * (j))
#define XB_XSUB(j)  (1280 + 64 * (j))
#define XB_XGEN(j)  (2304 + 64 * (j))
#define XB_TOP      3328
#define XB_TOPGEN   3392
#define XCD_BAR_WORDS 3456
#define XB_SPIN_CAP (1u << 18)

__device__ __forceinline__ unsigned xb_ld(unsigned* p)              { return __hip_atomic_load(p, __ATOMIC_RELAXED, __HIP_MEMORY_SCOPE_AGENT); }
__device__ __forceinline__ unsigned xb_add(unsigned* p, unsigned v) { return __hip_atomic_fetch_add(p, v, __ATOMIC_RELAXED, __HIP_MEMORY_SCOPE_AGENT); }
__device__ __forceinline__ unsigned xb_xcc_id() { return (unsigned)__builtin_amdgcn_s_getreg((3 << 11) | 20) & 0xFu; }
#define XB_SPIN(cond, bar) do { unsigned _sp = 0; while (cond) { __builtin_amdgcn_s_sleep(1); \
    if ((++_sp & 255u) == 0u) { if (xb_ld(&(bar)[XB_TMO])) break; if (_sp > XB_SPIN_CAP) { atomicAdd(&(bar)[XB_TMO], 1u); break; } } } } while (0)

struct XcdBarrier {
    unsigned* bar; unsigned x;
    volatile LAS unsigned* st;
};

__device__ __forceinline__ XcdBarrier xcd_barrier_post(unsigned* bar, volatile LAS unsigned* st) {
    XcdBarrier b; b.bar = bar; b.x = xb_xcc_id(); b.st = st;
    if (threadIdx.x == 0) (void)xb_add(&bar[XB_XCNT(b.x)], 1u);
    return b;
}
__device__ __forceinline__ void xcd_barrier_complete(unsigned* bar, unsigned x, unsigned& nloc, unsigned& nx) {
    const unsigned G = gridDim.x * gridDim.y * gridDim.z;
    unsigned sum, cnt, mine, sp = 0u;
    for (;;) {
        sum = 0u; cnt = 0u; mine = 0u;
#pragma unroll
        for (unsigned j = 0; j < 16; ++j) { const unsigned c = xb_ld(&bar[XB_XCNT(j)]); sum += c; cnt += (c > 0u) ? 1u : 0u; mine = (j == x) ? c : mine; }
        if (sum == G) break;
        __builtin_amdgcn_s_sleep(1);
        if ((++sp & 255u) == 0u) { if (xb_ld(&bar[XB_TMO])) break; if (sp > XB_SPIN_CAP) { atomicAdd(&bar[XB_TMO], 1u); break; } }
    }
    nloc = mine > 0u ? mine : 1u; nx = cnt > 0u ? cnt : 1u;
}

__device__ __forceinline__ void xcd_barrier(const XcdBarrier& b) {
    asm volatile("s_waitcnt vmcnt(0)" ::: "memory");
    __syncthreads();
    if (threadIdx.x == 0) {
        unsigned* bar = b.bar;
        __builtin_amdgcn_s_waitcnt(0);
        unsigned nloc = b.st[0], nx = b.st[1];
        if (nloc == 0u) { xcd_barrier_complete(bar, b.x, nloc, nx); b.st[0] = nloc; b.st[1] = nx; }
        const unsigned old = xb_add(&bar[XB_XSUB(b.x)], 1u);
        const unsigned gen = old / nloc;
        if (old + 1u == (gen + 1u) * nloc) {
            __builtin_amdgcn_fence(__ATOMIC_RELEASE, "agent");
            asm volatile("s_waitcnt vmcnt(0)" ::: "memory");
            const unsigned og = xb_add(&bar[XB_TOP], 1u);
            const unsigned tg = og / nx;
            if (og + 1u == (tg + 1u) * nx) xb_add(&bar[XB_TOPGEN], 1u);
            else XB_SPIN(xb_ld(&bar[XB_TOPGEN]) == tg, bar);
            __builtin_amdgcn_fence(__ATOMIC_ACQUIRE, "agent");
            xb_add(&bar[XB_XGEN(b.x)], 1u);
            asm volatile("s_waitcnt vmcnt(0)" ::: "memory");
        } else {
            XB_SPIN(xb_ld(&bar[XB_XGEN(b.x)]) == gen, bar);
            __builtin_amdgcn_fence(__ATOMIC_ACQUIRE, "agent");
            asm volatile("s_waitcnt vmcnt(0)" ::: "memory");
        }
    }
    __syncthreads();
}


struct Frame {
    LAS unsigned char* lds;
    volatile LAS unsigned* MISC;
    gu32* ctl;
    int tid, lane, wave, vcu, G;
};
struct Ptrs {
    const float *x_prompt, *x_sample, *state_conv, *state_hgrn, *norm_pre, *w_in, *conv_w, *lb_logits, *onorm, *w_out, *norm_post;
    float* out; unsigned char* ws;
};
struct Args { Ptrs p; int pad0, pad1; };
typedef const __attribute__((address_space(4))) Args* KArgs;
#if defined(__HIP_DEVICE_COMPILE__)
__device__ __forceinline__ Ptrs kargs() { KArgs p = (KArgs)__builtin_amdgcn_kernarg_segment_ptr(); asm volatile("" : "+s"(p)); return p->p; }
#else
__device__ __forceinline__ Ptrs kargs() { return Ptrs{}; }
#endif
__device__ __forceinline__ int opaque_tid() { int t = threadIdx.x; asm volatile("" : "+v"(t)); return t; }
__device__ __forceinline__ float wave_sum(float v) {
#pragma unroll
    for (int o = 1; o < 64; o <<= 1) v += __shfl_xor(v, o);
    return v;
}
template <bool PERMIN>
__device__ __forceinline__ void p0_transpose_item(const float* W, const float* gain, int K, int N, bf16* WT, LAS float* scr, int item, int lane) {
    const int nblk = N / 32, kb = item / nblk, nb = item % nblk, k0 = 64 * kb, n0 = 32 * nb;
#pragma unroll 8
    for (int i = 0; i < 32; ++i) { const int kk = 2 * i + (lane >> 5); float w = W[(size_t)(k0 + kk) * N + n0 + (lane & 31)]; if (gain) w *= gain[k0 + kk]; scr[kk * 33 + (lane & 31)] = w; }
    LDS_WAIT(); asm volatile("" ::: "memory");
    const int c = lane & 7;
#pragma unroll
    for (int j = 0; j < 4; ++j) { const int n = (lane >> 3) + 8 * j; const LAS float* s = scr + (8 * c) * 33 + n;
        v4u o; o.x = pk2(s[0 * 33], s[1 * 33]); o.y = pk2(s[2 * 33], s[3 * 33]); o.z = pk2(s[4 * 33], s[5 * 33]); o.w = pk2(s[6 * 33], s[7 * 33]);
        const int drow = PERMIN ? pg8::inproj_row(n0 + n) : (n0 + n);
        *(GAS v4u*)(WT + (size_t)drow * K + k0 + 8 * c) = o; }
    LDS_WAIT(); asm volatile("" ::: "memory");
}
struct RowRegs { f32x4 v[4]; };
__device__ __forceinline__ RowRegs row_load(const float* p, int lane) { RowRegs r; const GAS f32x4* q = (const GAS f32x4*)p + lane;
#pragma unroll
    for (int j = 0; j < 4; ++j) r.v[j] = q[64 * j]; return r; }
__device__ __forceinline__ float row_ssq(const RowRegs& r) { float s = 0.f;
#pragma unroll
    for (int j = 0; j < 4; ++j) s += (r.v[j].x * r.v[j].x + r.v[j].y * r.v[j].y) + (r.v[j].z * r.v[j].z + r.v[j].w * r.v[j].w); return wave_sum(s); }
__device__ __forceinline__ void row_store_f32(float* p, const RowRegs& r, int lane) { GAS f32x4* q = (GAS f32x4*)p + lane;
#pragma unroll
    for (int j = 0; j < 4; ++j) q[64 * j] = r.v[j]; }
__device__ __forceinline__ void row_store_bf16(bf16* p, const RowRegs& r, int lane) { GAS v2u* q = (GAS v2u*)p + lane;
#pragma unroll
    for (int j = 0; j < 4; ++j) { v2u w; w.x = pk2(r.v[j].x, r.v[j].y); w.y = pk2(r.v[j].z, r.v[j].w); q[64 * j] = w; } }


__device__ __forceinline__ void p0_prologue(Frame& F) {
    const Ptrs A = kargs();
    const int tid = opaque_tid(), lane = tid & 63, wave = __builtin_amdgcn_readfirstlane(tid >> 6);
    LAS float* scr = (LAS float*)(F.lds + RING_OFF + wave * 16384);
    const int gw = F.vcu * NWAVES + wave, NGW = F.G * NWAVES;
    constexpr int I_IN = (D / 64) * (NPROJ / 32), I_OUT = (D / 64) * (D / 32);
    constexpr int NITEMS = DEPTH * (I_IN + I_OUT);
    for (int it = gw; it < NITEMS; it += NGW) {
        const int l = it / (I_IN + I_OUT), r = it % (I_IN + I_OUT);
        if (r < I_IN) p0_transpose_item<true>(A.w_in + (size_t)l * D * NPROJ, A.norm_pre + l * D, D, NPROJ, (bf16*)(A.ws + WS_WIN) + (size_t)l * NPROJ * D, scr, r, lane);
        else p0_transpose_item<false>(A.w_out + (size_t)l * D * D, nullptr, D, D, (bf16*)(A.ws + WS_WOUT) + (size_t)l * D * D, scr, r - I_IN, lane);
    }
    float* rstd = (float*)(A.ws + WS_MISC + 65536); bf16* XB = (bf16*)(A.ws + WS_XB);
    for (int m = gw; m < M; m += NGW) {
        const float* src = m < MP ? A.x_prompt + (size_t)m * D : A.x_sample + (size_t)(m - MP) * D;
        RowRegs r = row_load(src, lane);
        const float ss = row_ssq(r);
        row_store_f32(A.out + OUT_Y + (size_t)m * D, r, lane); row_store_bf16(XB + (size_t)m * D, r, lane);
        if (lane == 0) rstd[m] = 1.0f / sqrtf(ss * (1.0f / D) + RMS_EPS);
    }
    if (blockIdx.x == 0) {
        float* LB = (float*)(A.ws + WS_MISC);
        for (int c = tid; c < D; c += NWAVES * 64) { const float l0 = A.lb_logits[c], l1 = A.lb_logits[D + c]; LB[c] = 0.f; LB[D + c] = 1.0f / (1.0f + __expf(l0 - l1)); }
    }
}
__device__ __forceinline__ void post_phase(Frame& F, int layer) {
    const Ptrs A = kargs();
    const int tid = opaque_tid(), lane = tid & 63, wave = __builtin_amdgcn_readfirstlane(tid >> 6);
    const int gw = F.vcu * NWAVES + wave, NGW = F.G * NWAVES;
    float* rstd = (float*)(A.ws + WS_MISC + 65536); bf16* XB = (bf16*)(A.ws + WS_XB); const float* Y = (const float*)(A.ws + WS_Y);
    const RowRegs g = row_load(A.norm_post + layer * D, lane);
    for (int m = gw; m < M; m += NGW) {
        RowRegs y = row_load(Y + (size_t)m * D, lane); RowRegs x = row_load(A.out + OUT_Y + (size_t)m * D, lane);
        const float ry = 1.0f / sqrtf(row_ssq(y) * (1.0f / D) + RMS_EPS);
#pragma unroll
        for (int j = 0; j < 4; ++j) x.v[j] = x.v[j] + (y.v[j] * ry) * g.v[j];
        const float ss = row_ssq(x);
        row_store_f32(A.out + OUT_Y + (size_t)m * D, x, lane);
        if (layer < DEPTH - 1) { row_store_bf16(XB + (size_t)m * D, x, lane); if (lane == 0) rstd[m] = 1.0f / sqrtf(ss * (1.0f / D) + RMS_EPS); }
    }
}
struct Row16 { v4u a, b; };
__device__ __forceinline__ Row16 ld16(const bf16* p) { Row16 r; r.a = *(const GAS v4u*)p; r.b = *(const GAS v4u*)(p + 8); return r; }
__device__ __forceinline__ void unpack16(const Row16& r, float (&f)[16]) {
    f[0] = bflo(r.a.x); f[1] = bfhi(r.a.x); f[2] = bflo(r.a.y); f[3] = bfhi(r.a.y); f[4] = bflo(r.a.z); f[5] = bfhi(r.a.z); f[6] = bflo(r.a.w); f[7] = bfhi(r.a.w);
    f[8] = bflo(r.b.x); f[9] = bfhi(r.b.x); f[10] = bflo(r.b.y); f[11] = bfhi(r.b.y); f[12] = bflo(r.b.z); f[13] = bfhi(r.b.z); f[14] = bflo(r.b.w); f[15] = bfhi(r.b.w); }
__device__ __forceinline__ void st16(bf16* p, const float (&f)[16]) {
    v4u a, b; a.x = pk2(f[0], f[1]); a.y = pk2(f[2], f[3]); a.z = pk2(f[4], f[5]); a.w = pk2(f[6], f[7]); b.x = pk2(f[8], f[9]); b.y = pk2(f[10], f[11]); b.z = pk2(f[12], f[13]); b.w = pk2(f[14], f[15]);
    *(GAS v4u*)p = a; *(GAS v4u*)(p + 8) = b; }
__device__ __forceinline__ void ldf16(const float* p, float (&f)[16]) {
#pragma unroll
    for (int i = 0; i < 4; ++i) { const f32x4 v = *(const GAS f32x4*)(p + 4 * i); f[4 * i] = v.x; f[4 * i + 1] = v.y; f[4 * i + 2] = v.z; f[4 * i + 3] = v.w; } }
__device__ __forceinline__ void conv_prep_phase(Frame& F, int jl) {
    const Ptrs A = kargs();
    const int tid = opaque_tid(), lane = tid & 63, wave = __builtin_amdgcn_readfirstlane(tid >> 6);
    const int gw = F.vcu * NWAVES + wave, NGW = F.G * NWAVES;
    const bf16* U = (const bf16*)(A.ws + WS_A0); const bf16* P = (const bf16*)(A.ws + WS_A1); bf16* G = (bf16*)(A.ws + WS_A2);
    const int c0 = 16 * lane;
    float w0[16], w1[16], w2[16];
    ldf16(A.conv_w + (size_t)(jl * 3 + 0) * D + c0, w0); ldf16(A.conv_w + (size_t)(jl * 3 + 1) * D + c0, w1); ldf16(A.conv_w + (size_t)(jl * 3 + 2) * D + c0, w2);
    for (int m = gw; m < M; m += NGW) {
        float u0[16], um1[16], um2[16], p[16], o[16];
        unpack16(ld16(U + (size_t)m * D + c0), u0); unpack16(ld16(P + (size_t)m * D + c0), p);
        int t; const float* st = nullptr;
        if (m < MP) t = m & (SEQ - 1); else { const int rs = m - MP; t = rs & 3; st = A.state_conv + ((size_t)(jl * DEC_BATCH + (rs >> 2)) * 2) * D + c0; }
        if (t >= 1) unpack16(ld16(U + (size_t)(m - 1) * D + c0), um1);
        else if (st) ldf16(st + D, um1);
        else {
#pragma unroll
            for (int i = 0; i < 16; ++i) um1[i] = 0.f; }
        if (t >= 2) unpack16(ld16(U + (size_t)(m - 2) * D + c0), um2);
        else if (st) ldf16(st + (t == 1 ? D : 0), um2);
        else {
#pragma unroll
            for (int i = 0; i < 16; ++i) um2[i] = 0.f; }
#pragma unroll
        for (int i = 0; i < 16; ++i) o[i] = p[i] * (w0[i] * um2[i] + w1[i] * um1[i] + w2[i] * u0[i]);
        st16(G + (size_t)m * D + c0, o);
    }
}
__device__ __forceinline__ void hgrn_prep_phase(Frame& F, int jl) {
    const Ptrs A = kargs();
    const int tid = opaque_tid(), lane = tid & 63, wave = __builtin_amdgcn_readfirstlane(tid >> 6);
    const int gw = F.vcu * NWAVES + wave, NGW = F.G * NWAVES;
    const bf16* O = (const bf16*)(A.ws + WS_A5); const bf16* SZ = (const bf16*)(A.ws + WS_A4); bf16* G = (bf16*)(A.ws + WS_A2);
    const int c0 = 16 * lane;
    float gn[16]; ldf16(A.onorm + (size_t)jl * HD + (c0 & (HD - 1)), gn);
    for (int m = gw; m < MP; m += NGW) {
        float o[16], z[16], g[16];
        unpack16(ld16(O + (size_t)m * D + c0), o); unpack16(ld16(SZ + (size_t)m * D + c0), z);
        float s = 0.f;
#pragma unroll
        for (int i = 0; i < 16; ++i) s += o[i] * o[i];
        s += __shfl_xor(s, 1); s += __shfl_xor(s, 2); s += __shfl_xor(s, 4);
        const float rs = 1.0f / sqrtf(s * (1.0f / HD) + RMS_EPS);
#pragma unroll
        for (int i = 0; i < 16; ++i) g[i] = o[i] * rs * gn[i] * z[i];
        st16(G + (size_t)m * D + c0, g);
    }
}
constexpr int R_B = 0;
constexpr int R_QT = 32768;
constexpr int R_KT = R_QT + 17408;
constexpr int R_KTT = R_KT + 17408;
constexpr int R_VT = R_KTT + 18432;
constexpr int R_SPT = R_VT + 4608;
constexpr int R_AM = R_SPT + 8704;
constexpr int R_TOT = R_AM + 9216;
constexpr int R_VEC = R_TOT + 2048;
constexpr int R_END = R_VEC + 2048;
static_assert(R_END <= RING_BYTES, "recurrence LDS map");
constexpr int QS = 136, TS = 72;

__device__ __forceinline__ void hgrn_prompt_phase(Frame& F, int jl) {
    const Ptrs A = kargs();
    const bf16* Q = (const bf16*)(A.ws + WS_A0); const bf16* KK = (const bf16*)(A.ws + WS_A1); const bf16* V = (const bf16*)(A.ws + WS_A3);
    const float* LOGF = (const float*)(A.ws + WS_F0); bf16* O = (bf16*)(A.ws + WS_A5);
    LAS unsigned char* L = F.lds + RING_OFF;
    LAS float* Bc = (LAS float*)(L + R_B); LAS bf16* QT = (LAS bf16*)(L + R_QT); LAS bf16* KT = (LAS bf16*)(L + R_KT); LAS bf16* KTT = (LAS bf16*)(L + R_KTT);
    LAS bf16* VT = (LAS bf16*)(L + R_VT); LAS bf16* SPT = (LAS bf16*)(L + R_SPT); LAS bf16* AM = (LAS bf16*)(L + R_AM); LAS float* TOT = (LAS float*)(L + R_TOT); LAS float* VEC = (LAS float*)(L + R_VEC);
    const int tid = opaque_tid(), w = __builtin_amdgcn_readfirstlane(tid >> 6), lane = tid & 63, fr = lane & 15, fq = lane >> 4;
    const int lt = tid >> 3, lc = (tid & 7) * 16;
    const int ck = tid & 127, cseg = tid >> 7;
    for (int item = blockIdx.x; item < BATCH * NHEAD * 4; item += F.G) {
        const int b = item >> 5, h = (item >> 2) & 7, vs = item & 3;
        const size_t base = (size_t)b * SEQ * D + h * HD;
        f32x4 S[2]; S[0] = (f32x4){0.f, 0.f, 0.f, 0.f}; S[1] = S[0];
        v4u rq[2], rk[2]; v2u rv; f32x4 rl[4];
        { const size_t o = base + (size_t)lt * D + lc;
          rq[0] = *(const GAS v4u*)(Q + o); rq[1] = *(const GAS v4u*)(Q + o + 8); rk[0] = *(const GAS v4u*)(KK + o); rk[1] = *(const GAS v4u*)(KK + o + 8);
          rv = *(const GAS v2u*)(V + base + (size_t)lt * D + vs * 32 + (tid & 7) * 4);
#pragma unroll
          for (int i = 0; i < 4; ++i) rl[i] = *(const GAS f32x4*)(LOGF + o + 4 * i); }
        for (int c = 0; c < SEQ / 64; ++c) {
            const size_t rowc = base + (size_t)(c * 64) * D;
#pragma unroll
            for (int i = 0; i < 4; ++i) *(LAS f32x4*)(Bc + lt * 128 + lc + 4 * i) = rl[i];
            if (c + 1 < SEQ / 64) { const size_t o = rowc + (size_t)(64 + lt) * D + lc;
#pragma unroll
                for (int i = 0; i < 4; ++i) rl[i] = *(const GAS f32x4*)(LOGF + o + 4 * i); }
            __syncthreads();
            { float run = 0.f;
#pragma unroll
              for (int i = 0; i < 16; ++i) { run += Bc[(16 * cseg + i) * 128 + ck]; Bc[(16 * cseg + i) * 128 + ck] = run; }
              TOT[cseg * 128 + ck] = run; }
            __syncthreads();
            { float off = 0.f;
              for (int s = 0; s < cseg; ++s) off += TOT[s * 128 + ck];
              if (cseg > 0) {
#pragma unroll
                  for (int i = 0; i < 16; ++i) Bc[(16 * cseg + i) * 128 + ck] += off; }
              if (cseg == 0) { const float R = TOT[ck] + TOT[128 + ck], B63 = R + TOT[256 + ck] + TOT[384 + ck];
                  VEC[ck] = __expf(R); VEC[128 + ck] = __expf(B63); VEC[256 + ck] = __expf(B63 - R); VEC[384 + ck] = R; } }
            __syncthreads();
            { float q[16], k[16];
              { Row16 t; t.a = rq[0]; t.b = rq[1]; unpack16(t, q); t.a = rk[0]; t.b = rk[1]; unpack16(t, k); }
#pragma unroll
              for (int i = 0; i < 16; ++i) { const float d = Bc[lt * 128 + lc + i] - VEC[384 + lc + i]; q[i] *= __expf(d); k[i] *= __expf(-d); }
              v4u a, bb;
              a.x = pk2(q[0], q[1]); a.y = pk2(q[2], q[3]); a.z = pk2(q[4], q[5]); a.w = pk2(q[6], q[7]); bb.x = pk2(q[8], q[9]); bb.y = pk2(q[10], q[11]); bb.z = pk2(q[12], q[13]); bb.w = pk2(q[14], q[15]);
              *(LAS v4u*)(QT + lt * QS + lc) = a; *(LAS v4u*)(QT + lt * QS + lc + 8) = bb;
              a.x = pk2(k[0], k[1]); a.y = pk2(k[2], k[3]); a.z = pk2(k[4], k[5]); a.w = pk2(k[6], k[7]); bb.x = pk2(k[8], k[9]); bb.y = pk2(k[10], k[11]); bb.z = pk2(k[12], k[13]); bb.w = pk2(k[14], k[15]);
              *(LAS v4u*)(KT + lt * QS + lc) = a; *(LAS v4u*)(KT + lt * QS + lc + 8) = bb;
#pragma unroll
              for (int i = 0; i < 16; ++i) KTT[(lc + i) * TS + lt] = (bf16)f2bf(k[i]);
              const int v0 = (tid & 7) * 4;
              VT[(v0 + 0) * TS + lt] = (bf16)(rv.x & 0xffffu); VT[(v0 + 1) * TS + lt] = (bf16)(rv.x >> 16); VT[(v0 + 2) * TS + lt] = (bf16)(rv.y & 0xffffu); VT[(v0 + 3) * TS + lt] = (bf16)(rv.y >> 16);
#pragma unroll
              for (int nv = 0; nv < 2; ++nv) { const int k0 = 16 * w + 4 * fq; v2u sp;
                  sp.x = pk2(S[nv][0] * VEC[k0], S[nv][1] * VEC[k0 + 1]); sp.y = pk2(S[nv][2] * VEC[k0 + 2], S[nv][3] * VEC[k0 + 3]);
                  *(LAS v2u*)(SPT + (16 * nv + fr) * QS + k0) = sp; } }
            if (c + 1 < SEQ / 64) { const size_t o = rowc + (size_t)(64 + lt) * D + lc;
                rq[0] = *(const GAS v4u*)(Q + o); rq[1] = *(const GAS v4u*)(Q + o + 8); rk[0] = *(const GAS v4u*)(KK + o); rk[1] = *(const GAS v4u*)(KK + o + 8);
                rv = *(const GAS v2u*)(V + rowc + (size_t)(64 + lt) * D + vs * 32 + (tid & 7) * 4); }
            __syncthreads();
            { const int tb = w >> 1;
#pragma unroll
              for (int sbi = 0; sbi < 2; ++sbi) { const int sb = 2 * (w & 1) + sbi; f32x4 acc = (f32x4){0.f, 0.f, 0.f, 0.f};
                  if (sb <= tb) {
#pragma unroll
                      for (int kk = 0; kk < 4; ++kk) { const bf16x8 av = *(const LAS bf16x8*)(QT + (16 * tb + fr) * QS + 32 * kk + 8 * fq), bv = *(const LAS bf16x8*)(KT + (16 * sb + fr) * QS + 32 * kk + 8 * fq);
                          acc = __builtin_amdgcn_mfma_f32_16x16x32_bf16(av, bv, acc, 0, 0, 0); } }
                  const int s = 16 * sb + fr;
#pragma unroll
                  for (int rg = 0; rg < 4; ++rg) { const int t = 16 * tb + 4 * fq + rg; AM[t * TS + s] = (bf16)f2bf((sb <= tb && s <= t) ? acc[rg] : 0.f); } }
#pragma unroll
              for (int nv = 0; nv < 2; ++nv) { f32x4 acc = (f32x4){0.f, 0.f, 0.f, 0.f};
#pragma unroll
                  for (int kk = 0; kk < 2; ++kk) { const bf16x8 av = *(const LAS bf16x8*)(KTT + (16 * w + fr) * TS + 32 * kk + 8 * fq), bv = *(const LAS bf16x8*)(VT + (16 * nv + fr) * TS + 32 * kk + 8 * fq);
                      acc = __builtin_amdgcn_mfma_f32_16x16x32_bf16(av, bv, acc, 0, 0, 0); }
#pragma unroll
                  for (int rg = 0; rg < 4; ++rg) { const int k = 16 * w + 4 * fq + rg; S[nv][rg] = VEC[128 + k] * S[nv][rg] + VEC[256 + k] * acc[rg]; } } }
            __syncthreads();
            { const int tb = w >> 1, nv = w & 1; f32x4 acc = (f32x4){0.f, 0.f, 0.f, 0.f};
#pragma unroll
              for (int kk = 0; kk < 2; ++kk) { const bf16x8 av = *(const LAS bf16x8*)(AM + (16 * tb + fr) * TS + 32 * kk + 8 * fq), bv = *(const LAS bf16x8*)(VT + (16 * nv + fr) * TS + 32 * kk + 8 * fq);
                  acc = __builtin_amdgcn_mfma_f32_16x16x32_bf16(av, bv, acc, 0, 0, 0); }
#pragma unroll
              for (int kk = 0; kk < 4; ++kk) { const bf16x8 av = *(const LAS bf16x8*)(QT + (16 * tb + fr) * QS + 32 * kk + 8 * fq), bv = *(const LAS bf16x8*)(SPT + (16 * nv + fr) * QS + 32 * kk + 8 * fq);
                  acc = __builtin_amdgcn_mfma_f32_16x16x32_bf16(av, bv, acc, 0, 0, 0); }
#pragma unroll
              for (int rg = 0; rg < 4; ++rg) { const int t = 16 * tb + 4 * fq + rg; O[rowc + (size_t)t * D + vs * 32 + 16 * nv + fr] = (bf16)f2bf(acc[rg]); } }
        }
        { float* HP = A.out + OUT_HP + ((size_t)((jl * BATCH + b) * NHEAD + h) * HD) * HD;
#pragma unroll
          for (int nv = 0; nv < 2; ++nv)
#pragma unroll
              for (int rg = 0; rg < 4; ++rg) HP[(size_t)(16 * w + 4 * fq + rg) * HD + vs * 32 + 16 * nv + fr] = S[nv][rg]; }
        __syncthreads();
    }
}
__device__ __forceinline__ void hgrn_sample_phase(Frame& F, int jl) {
    const Ptrs A = kargs();
    const bf16* Q = (const bf16*)(A.ws + WS_A0); const bf16* KK = (const bf16*)(A.ws + WS_A1); const bf16* V = (const bf16*)(A.ws + WS_A3); const bf16* SZ = (const bf16*)(A.ws + WS_A4);
    const float* LOGF = (const float*)(A.ws + WS_F0); bf16* G = (bf16*)(A.ws + WS_A2);
    LAS float* L = (LAS float*)(F.lds + RING_OFF);
    LAS float* vq = L, *vk = L + 512, *vf = L + 1024, *vv = L + 1536, *vz = L + 2048, *red = L + 2560  , *ssw = L + 2560 + 8192  ;
    const int tid = opaque_tid(), lane = tid & 63, wave = __builtin_amdgcn_readfirstlane(tid >> 6);
    for (int it = blockIdx.x; it < DEC_BATCH * NHEAD; it += F.G) {
        const int b = it >> 3, h = it & 7; const size_t rbase = (size_t)(MP + 4 * b) * D + h * HD;
        const int v0 = 4 * (tid & 31), k0 = 8 * (tid >> 5);
        const float* S0 = A.state_hgrn + ((size_t)((jl * DEC_BATCH + b) * NHEAD + h) * HD) * HD;
        f32x4 S[8];
#pragma unroll
        for (int i = 0; i < 8; ++i) S[i] = *(const GAS f32x4*)(S0 + (size_t)(k0 + i) * HD + v0);
        { const int t = tid >> 7, k = tid & 127; const size_t o = rbase + (size_t)t * D + k;
          vq[tid] = bf1(Q[o]); vk[tid] = bf1(KK[o]); vf[tid] = __expf(LOGF[o]); vv[tid] = bf1(V[o]); vz[tid] = bf1(SZ[o]); }
        __syncthreads();
        f32x4 op[4];
#pragma unroll
        for (int t = 0; t < 4; ++t) { op[t] = (f32x4){0.f, 0.f, 0.f, 0.f}; const f32x4 vt = *(const LAS f32x4*)(vv + t * 128 + v0);
#pragma unroll
            for (int i = 0; i < 8; ++i) { const float f = vf[t * 128 + k0 + i], kk = vk[t * 128 + k0 + i], qq = vq[t * 128 + k0 + i];
                S[i] = S[i] * f + vt * kk; op[t] = op[t] + S[i] * qq; } }
        float* S1 = A.out + OUT_HS + ((size_t)((jl * DEC_BATCH + b) * NHEAD + h) * HD) * HD;
#pragma unroll
        for (int i = 0; i < 8; ++i) *(GAS f32x4*)(S1 + (size_t)(k0 + i) * HD + v0) = S[i];
#pragma unroll
        for (int t = 0; t < 4; ++t) *(LAS f32x4*)(red + (t * 16 + (tid >> 5)) * 128 + v0) = op[t];
        __syncthreads();
        { const int t = tid >> 7, v = tid & 127; float o = 0.f;
#pragma unroll
          for (int kq = 0; kq < 16; ++kq) o += red[(t * 16 + kq) * 128 + v];
          const float ss = wave_sum(o * o);
          if (lane == 0) ssw[wave] = ss;
          __syncthreads();
          const float rs = 1.0f / sqrtf((ssw[2 * t] + ssw[2 * t + 1]) * (1.0f / HD) + RMS_EPS);
          G[rbase + (size_t)t * D + v] = (bf16)f2bf(o * rs * A.onorm[jl * HD + v] * vz[tid]); }
        __syncthreads();
    }
}
__global__ void __launch_bounds__(NWAVES * 64, 2) fwd_kernel(Args args) {
    extern __shared__ __attribute__((aligned(16))) unsigned char lds[];
    Frame F;
    F.lds = (LAS unsigned char*)lds;
    F.MISC = (volatile LAS unsigned*)(F.lds + MISC_OFF);
    F.tid = threadIdx.x; F.lane = F.tid & 63; F.wave = __builtin_amdgcn_readfirstlane(F.tid >> 6);
    F.G = gridDim.x; { const int bx = blockIdx.x; F.vcu = (F.G % 8 == 0) ? (bx % 8) * (F.G / 8) + bx / 8 : bx; }
    F.ctl = (gu32*)(kargs().ws + WS_CTL);
    for (int u = F.tid; u < (LDS_BYTES - LDSCTL_OFF) / 4; u += NWAVES * 64) ((LAS unsigned*)(F.lds + LDSCTL_OFF))[u] = 0u;
    __syncthreads();
    XcdBarrier bar = xcd_barrier_post((unsigned*)(F.ctl + CW_BAR), F.MISC + 8);
#define GRID_BAR() xcd_barrier(bar)

    p0_prologue(F);
    GRID_BAR();
    for (int layer = 0; layer < DEPTH; ++layer) {
        const int jl = layer >> 1;
        const Ptrs A = kargs(); unsigned char* ws = A.ws;
        const float* rstd = (const float*)(ws + WS_MISC + 65536); const float* LB = (const float*)(ws + WS_MISC); const bf16* XB = (const bf16*)(ws + WS_XB);
        const bf16* WinT = (const bf16*)(ws + WS_WIN) + (size_t)layer * NPROJ * D;
        const bf16* WoutT = (const bf16*)(ws + WS_WOUT) + (size_t)layer * D * D;
        if ((layer & 1) == 0) {
            { pg8::Gemm g{XB, WinT, M, NPROJ, D}; pg8::StaticOrder S; S.init(M, NPROJ, F.G, (int)blockIdx.x);
              pg8::EpiConvIn E{rstd, (bf16*)(ws + WS_A0), (bf16*)(ws + WS_A1), A.out + OUT_CONVP + (size_t)jl * 8 * 2 * D, A.out + OUT_CONVS + (size_t)jl * 128 * 2 * D};
              pg8::gemm_phase<pg8::EpiConvIn, pg8::StaticOrder, true, true>(F.lds + RING_OFF, g, S, E); }
            GRID_BAR();
            conv_prep_phase(F, jl);
            GRID_BAR();
        } else {
            { pg8::Gemm g{XB, WinT, M, NPROJ, D}; pg8::StaticOrder S; S.init(M, NPROJ, F.G, (int)blockIdx.x);
              pg8::EpiHgrnIn E{rstd, LB + jl * D, (bf16*)(ws + WS_A0), (bf16*)(ws + WS_A1), (bf16*)(ws + WS_A3), (bf16*)(ws + WS_A4), (float*)(ws + WS_F0)};
              pg8::gemm_phase<pg8::EpiHgrnIn, pg8::StaticOrder, true, true>(F.lds + RING_OFF, g, S, E); }
            GRID_BAR();
            hgrn_prompt_phase(F, jl);
            hgrn_sample_phase(F, jl);
            GRID_BAR();
            hgrn_prep_phase(F, jl);
            GRID_BAR();
        }
        { pg8::Gemm g{(const bf16*)(ws + WS_A2), WoutT, M, D, D}; pg8::StaticOrder S; S.init(M, D, F.G, (int)blockIdx.x);
          pg8::EpiF32 E{(float*)(ws + WS_Y)};
          pg8::gemm_phase<pg8::EpiF32, pg8::StaticOrder, true, true>(F.lds + RING_OFF, g, S, E); }
        GRID_BAR();
        post_phase(F, layer);
        if (layer + 1 < DEPTH) GRID_BAR();
    }
}

extern "C" void kernel_launch(void* const* d_in, const int* in_sizes, int n_in, void* d_out, int out_size, void* d_ws, size_t ws_size, hipStream_t stream) {
    static int grid = 0;
    if (grid == 0) {
        if (n_in != 11 || (size_t)out_size != OUT_END || ws_size < WS_END) { fprintf(stderr, "kernel_launch: unexpected shapes: n_in %d out %d ws %zu\n", n_in, out_size, ws_size); grid = -1; return; }
        int dev = 0, cus = 0, per_cu = 0;
        if (hipGetDevice(&dev) != hipSuccess || hipDeviceGetAttribute(&cus, hipDeviceAttributeMultiprocessorCount, dev) != hipSuccess) { grid = -1; return; }
        if (hipFuncSetAttribute((const void*)fwd_kernel, hipFuncAttributeMaxDynamicSharedMemorySize, LDS_BYTES) != hipSuccess) { fprintf(stderr, "kernel_launch: hipFuncSetAttribute failed\n"); grid = -1; return; }
        if (hipOccupancyMaxActiveBlocksPerMultiprocessor(&per_cu, (const void*)fwd_kernel, NWAVES * 64, LDS_BYTES) != hipSuccess || per_cu < 1)
            fprintf(stderr, "kernel_launch: note: occupancy query reports %d workgroups per CU\n", per_cu);
        (void)hipGetLastError();
        grid = cus;
    }
    if (grid < 0) return;
    if (hipMemsetAsync((char*)d_ws + WS_CTL, 0, CTL_ZERO_BYTES, stream) != hipSuccess) { fprintf(stderr, "kernel_launch: hipMemsetAsync failed\n"); return; }
    Args a{};
    a.p.x_prompt = (const float*)d_in[0]; a.p.x_sample = (const float*)d_in[1]; a.p.state_conv = (const float*)d_in[2]; a.p.state_hgrn = (const float*)d_in[3];
    a.p.norm_pre = (const float*)d_in[4]; a.p.w_in = (const float*)d_in[5]; a.p.conv_w = (const float*)d_in[6]; a.p.lb_logits = (const float*)d_in[7];
    a.p.onorm = (const float*)d_in[8]; a.p.w_out = (const float*)d_in[9]; a.p.norm_post = (const float*)d_in[10];
    a.p.out = (float*)d_out; a.p.ws = (unsigned char*)d_ws;
    hipLaunchKernelGGL(fwd_kernel, dim3(grid), dim3(NWAVES * 64), LDS_BYTES, stream, a);
    const hipError_t le = hipPeekAtLastError();
    if (le != hipSuccess) fprintf(stderr, "kernel_launch: launch failed: %s\n", hipGetErrorName(le));
}
```

```cpp
#include <hip/hip_runtime.h>
#include <cstdio>
#include <cstdint>
namespace pg8 {
#define PG8_LAS __attribute__((address_space(3)))
typedef unsigned short bf16_t;
typedef short bf16x8 __attribute__((ext_vector_type(8)));
typedef float f32x4 __attribute__((ext_vector_type(4)));
typedef unsigned u32x4 __attribute__((ext_vector_type(4)));
constexpr int BM = 256, BK = 64, HALF = 128, HTB = HALF * BK * 2  , STAGE_BYTES = 8 * HTB, NXCD = 8, WGM = 8;

__host__ __device__ __forceinline__ int lds_byte(int r, int c) { const int st = (r >> 4) * 2 + (c >> 5), rr = r & 15, cc = c & 31, ob = rr * 64 + cc * 2; return st * 1024 + (ob ^ (((ob >> 9) & 1) << 5)); }
__host__ __device__ __forceinline__ void stage_rc(int b, int& R, int& C) { const int st = b / 1024, sb = b % 1024, swz = sb ^ (((sb >> 9) & 1) << 5); R = (st >> 1) * 16 + swz / 64; C = (st & 1) * 32 + (swz % 64) / 2; }
__host__ __device__ __forceinline__ int perm32(int rho) { const int n = rho >> 4, i = rho & 15; return 8 * (i >> 2) + 4 * n + (i & 3); }

struct Unit { int pm, pn; };
struct Gemm { const bf16_t* A; const bf16_t* Bt; int M, N, K; };

struct StaticOrder {
    int nM, nN, nwg, G, c;
    __host__ __device__ void init(int M, int N, int G_, int c_) { nM = M / BM; nN = N / BM; nwg = nM * nN; G = G_; c = c_; }
    __host__ __device__ bool next(int i, Unit& u) const {
        const long L = (long)i * G + c; if (L >= nwg) return false;
        int wgid = (int)L; { const int q = nwg / NXCD, r = nwg % NXCD, xcd = wgid % NXCD, off = wgid / NXCD; wgid = (xcd < r ? xcd * (q + 1) : r * (q + 1) + (xcd - r) * q) + off; }
        const int nig = WGM * nN, gid = wgid / nig, fm = gid * WGM, gsz = (nM - fm) < WGM ? (nM - fm) : WGM;
        u.pm = fm + ((wgid % nig) % gsz); u.pn = (wgid % nig) / gsz; return true;
    }
    __device__ __forceinline__ void a_ready(const Unit&) const {}
    __device__ __forceinline__ void done(const Unit&) const {}
};

__device__ __forceinline__ unsigned cvt_pk_bf16(float lo, float hi) { unsigned r; asm volatile("v_cvt_pk_bf16_f32 %0, %1, %2" : "=v"(r) : "v"(lo), "v"(hi)); return r; }
typedef float f32x2 __attribute__((ext_vector_type(2)));
typedef unsigned u32x2 __attribute__((ext_vector_type(2)));
typedef __bf16 bf16x2_t __attribute__((ext_vector_type(2)));
__device__ __forceinline__ unsigned pkc(float lo, float hi) { const f32x2 v = {lo, hi}; return __builtin_bit_cast(unsigned, __builtin_convertvector(v, bf16x2_t)); }
__host__ __device__ __forceinline__ int inproj_row(int nsrc) { const int g = nsrc >> 10, cc = nsrc & 1023, pn = cc >> 6, ch = cc & 63; return 256 * pn + 128 * (g >> 1) + 32 * (ch >> 4) + 16 * (g & 1) + (ch & 15); }
__device__ __forceinline__ float fsigmoid(float x) { return 1.0f / (1.0f + __expf(-x)); }

constexpr int ROWS_P = 16384, ROWS_ALL = 16896, DM = 1024;

struct EpiConvIn {
    static constexpr bool PERM = false, AFTER_DRAIN = false;
    const float* rstd; bf16_t* U; bf16_t* P; float* convp; float* convs;
    __device__ __forceinline__ void operator()(const f32x4 (&acc)[2][2][4][2], const Unit& u, int wr, int wc, int fr, int fq) const {
        const int ch0 = u.pn * 64 + wc * 16 + fq * 4;
#pragma unroll
        for (int ai = 0; ai < 2; ++ai)
#pragma unroll
            for (int m = 0; m < 4; ++m) {
                const int r = u.pm * BM + ai * HALF + wr * 64 + m * 16 + fr;
                const float rs = rstd[r];
                const f32x4 v = acc[ai][0][m][0] * rs, bg = acc[ai][0][m][1] * rs, cg = acc[ai][1][m][0] * rs, z = acc[ai][1][m][1] * rs;
                const f32x4 uu = cg * v; f32x4 pp;
#pragma unroll
                for (int j = 0; j < 4; ++j) pp[j] = bg[j] * z[j] * fsigmoid(z[j]);
                u32x2 wu, wp; wu.x = pkc(uu[0], uu[1]); wu.y = pkc(uu[2], uu[3]); wp.x = pkc(pp[0], pp[1]); wp.y = pkc(pp[2], pp[3]);
                *(u32x2*)(U + (size_t)r * DM + ch0) = wu; *(u32x2*)(P + (size_t)r * DM + ch0) = wp;
                if (r < ROWS_P) { const int t = r & 2047; if (t >= 2046) *(f32x4*)(convp + ((size_t)(r >> 11) * 2 + (t - 2046)) * DM + ch0) = uu; }
                else { const int rs2 = r - ROWS_P, t = rs2 & 3; if (t >= 2) *(f32x4*)(convs + ((size_t)(rs2 >> 2) * 2 + (t - 2)) * DM + ch0) = uu; }
            }
    }
};
template <int CTRL> __device__ __forceinline__ float dpp_mov0(float x) { return __builtin_bit_cast(float, __builtin_amdgcn_update_dpp(0, __builtin_bit_cast(int, x), CTRL, 0xf, 0xf, false)); }
__device__ __forceinline__ float scan16(float x) { x += dpp_mov0<0x111>(x); x += dpp_mov0<0x112>(x); x += dpp_mov0<0x114>(x); x += dpp_mov0<0x118>(x); return x; }
struct EpiHgrnIn {
    static constexpr bool PERM = false, AFTER_DRAIN = false;
    const float* rstd; const float* lb; bf16_t* Q; bf16_t* KK; bf16_t* V; bf16_t* SZ; float* LOGF; float* DV;
    __device__ __forceinline__ void operator()(const f32x4 (&acc)[2][2][4][2], const Unit& u, int wr, int wc, int fr, int fq) const {
        const int ch0 = u.pn * 64 + wc * 16 + fq * 4;
        const f32x4 lbv = *(const f32x4*)(lb + ch0);
        const bool prompt = u.pm < 64;
#pragma unroll
        for (int ai = 0; ai < 2; ++ai) {
            f32x4 qv[4], kv[4], lv[4];
#pragma unroll
            for (int m = 0; m < 4; ++m) {
                const int r = u.pm * BM + ai * HALF + wr * 64 + m * 16 + fr;
                const float rs = rstd[r];
                const f32x4 qr = acc[ai][0][m][0] * rs, fp = acc[ai][0][m][1] * rs, iv = acc[ai][1][m][0] * rs, z = acc[ai][1][m][1] * rs;
                f32x4 sz;
#pragma unroll
                for (int j = 0; j < 4; ++j) {
                    qv[m][j] = qr[j] * fsigmoid(qr[j]) * 0.08838834764831845f;
                    const float e = __expf(-fabsf(fp[j])), r1 = 1.0f / (1.0f + e), r2 = e * r1, sg = fp[j] >= 0.f ? r1 : r2, nsg = fp[j] >= 0.f ? r2 : r1;
                    const float f = lbv[j] + (1.0f - lbv[j]) * sg;
                    float l = __logf(f), kk = (1.0f - lbv[j]) * nsg;
                    if (!(l >= -20.0f)) { l = -20.0f; kk = 1.0f - 2.0611536e-9f; }
                    lv[m][j] = l; kv[m][j] = kk; sz[j] = z[j] * fsigmoid(z[j]);
                }
                const size_t o = (size_t)r * DM + ch0;
                u32x2 w; w.x = pkc(iv[0], iv[1]); w.y = pkc(iv[2], iv[3]); *(u32x2*)(V + o) = w;
                w.x = pkc(sz[0], sz[1]); w.y = pkc(sz[2], sz[3]); *(u32x2*)(SZ + o) = w;
                if (!prompt) *(f32x4*)(LOGF + o) = lv[m];
            }
            if (prompt) {
                f32x4 tot[4];
#pragma unroll
                for (int m = 0; m < 4; ++m)
#pragma unroll
                    for (int j = 0; j < 4; ++j) { lv[m][j] = scan16(lv[m][j]); tot[m][j] = __shfl(lv[m][j], 15, 16); }
                const f32x4 R = tot[0] + tot[1], B63 = R + tot[2] + tot[3];
                f32x4 off = (f32x4){0.f, 0.f, 0.f, 0.f};
#pragma unroll
                for (int m = 0; m < 4; ++m) { const f32x4 d = lv[m] + off - R; off = off + tot[m];
#pragma unroll
                    for (int j = 0; j < 4; ++j) { qv[m][j] *= __expf(d[j]); kv[m][j] *= __expf(-d[j]); } }
                if (fr == 0) { const int chunk = u.pm * 4 + ai * 2 + wr; f32x4 e0, e1, e2;
#pragma unroll
                    for (int j = 0; j < 4; ++j) { e0[j] = __expf(R[j]); e1[j] = __expf(B63[j]); e2[j] = __expf(B63[j] - R[j]); }
                    *(f32x4*)(DV + (size_t)chunk * DM + ch0) = e0; *(f32x4*)(DV + (size_t)(256 + chunk) * DM + ch0) = e1; *(f32x4*)(DV + (size_t)(512 + chunk) * DM + ch0) = e2; }
            }
#pragma unroll
            for (int m = 0; m < 4; ++m) { const size_t o = (size_t)(u.pm * BM + ai * HALF + wr * 64 + m * 16 + fr) * DM + ch0;
                u32x2 w; w.x = pkc(qv[m][0], qv[m][1]); w.y = pkc(qv[m][2], qv[m][3]); *(u32x2*)(Q + o) = w;
                w.x = pkc(kv[m][0], kv[m][1]); w.y = pkc(kv[m][2], kv[m][3]); *(u32x2*)(KK + o) = w; }
        }
    }
};
struct EpiF32 {
    static constexpr bool PERM = false, AFTER_DRAIN = false;
    float* Y;
    __device__ __forceinline__ void operator()(const f32x4 (&acc)[2][2][4][2], const Unit& u, int wr, int wc, int fr, int fq) const {
#pragma unroll
        for (int ai = 0; ai < 2; ++ai)
#pragma unroll
            for (int m = 0; m < 4; ++m) {
                float* rowp = Y + (size_t)(u.pm * BM + ai * HALF + wr * 64 + m * 16 + fr) * DM + u.pn * BM + wc * 32 + 4 * fq;
#pragma unroll
                for (int bj = 0; bj < 2; ++bj)
#pragma unroll
                    for (int n = 0; n < 2; ++n) *(f32x4*)(rowp + bj * HALF + n * 16) = acc[ai][bj][m][n];
            }
    }
};

template <class Epi, class Sched, bool ALIGN_EPI = false, bool SP2 = false>
__device__ __forceinline__ void gemm_phase(PG8_LAS unsigned char* lds, const Gemm g, const Sched& S, const Epi& E) {
    const int tid = threadIdx.x, wid = __builtin_amdgcn_readfirstlane(tid >> 6), lane = tid & 63, wr = wid >> 2, wc = wid & 3, fr = lane & 15, fq = lane >> 4;
    const int K = g.K, nt = K / BK;
    unsigned voffA[2], voffB[2];
#pragma unroll
    for (int i = 0; i < 2; ++i) { int R, C; stage_rc(tid * 16 + i * 8192, R, C); const int Rb = Epi::PERM ? ((R & ~31) + perm32(R & 31)) : R;
        voffA[i] = (unsigned)(R * K + C) * 2u; voffB[i] = (unsigned)(Rb * K + C) * 2u; }
    const size_t kstep = (size_t)(BK * 2);
    const size_t hstep = (size_t)HALF * K * 2;
    const size_t tstep = 2 * hstep;
    const unsigned ldsw = (unsigned)wid * 1024u;
    const int aoff = lds_byte(wr * 64 + fr, fq * 8), boff = lds_byte(wc * 32 + fr, fq * 8);
#define PG8_SA(b, h) (((b) * 2 + (h)) * HTB)
#define PG8_SB(b, h) ((4 + (b) * 2 + (h)) * HTB)
#define PG8_STAGE(bufoff, gbase, voff) do { _Pragma("unroll") for (int _i = 0; _i < 2; ++_i) \
        __builtin_amdgcn_global_load_lds((const unsigned*)((const char*)(gbase) + (voff)[_i]), (PG8_LAS unsigned*)(lds + (bufoff) + ldsw + _i * 8192), 16, 0, 0); } while (0)
#define PG8_LDA(dst, b, h) do { _Pragma("unroll") for (int m = 0; m < 4; ++m) _Pragma("unroll") for (int k = 0; k < 2; ++k) dst[m][k] = *(const PG8_LAS bf16x8*)(lds + PG8_SA(b, h) + aoff + m * 2048 + k * 1024); } while (0)
#define PG8_LDB(dst, b, h) do { _Pragma("unroll") for (int n = 0; n < 2; ++n) _Pragma("unroll") for (int k = 0; k < 2; ++k) dst[n][k] = *(const PG8_LAS bf16x8*)(lds + PG8_SB(b, h) + boff + n * 2048 + k * 1024); } while (0)
#define PG8_MMA(ai, bj, At, Bt) do { __builtin_amdgcn_s_setprio(1); _Pragma("unroll") for (int m = 0; m < 4; ++m) _Pragma("unroll") for (int n = 0; n < 2; ++n) _Pragma("unroll") for (int k = 0; k < 2; ++k) \
        acc[ai][bj][m][n] = __builtin_amdgcn_mfma_f32_16x16x32_bf16(Bt[n][k], At[m][k], acc[ai][bj][m][n], 0, 0, 0); __builtin_amdgcn_s_setprio(0); } while (0)
#define PG8_WAIT_V(n) asm volatile("s_waitcnt vmcnt(" #n ")" ::: "memory")
#define PG8_WAIT_L(n) asm volatile("s_waitcnt lgkmcnt(" #n ")" ::: "memory")
#define PG8_BAR __builtin_amdgcn_s_barrier()
#define PG8_SCHED __builtin_amdgcn_sched_barrier(0)
    Unit cur, nxt; int ui = 0;
    if (!S.next(0, cur)) return;
    f32x4 acc[2][2][4][2];
#pragma unroll
    for (int a = 0; a < 2; ++a)
#pragma unroll
        for (int b = 0; b < 2; ++b)
#pragma unroll
            for (int m = 0; m < 4; ++m)
#pragma unroll
                for (int n = 0; n < 2; ++n) acc[a][b][m][n] = (f32x4){0.f, 0.f, 0.f, 0.f};
    bf16x8 At[4][2], B0[2][2], B1[2][2];
    const char* cA = (const char*)g.A + (size_t)cur.pm * tstep; const char* cB = (const char*)g.Bt + (size_t)cur.pn * tstep;
    S.a_ready(cur);
    if constexpr (SP2) {
        PG8_STAGE(PG8_SB(0, 0), cB, voffB); PG8_STAGE(PG8_SB(0, 1), cB + hstep, voffB); PG8_STAGE(PG8_SA(0, 0), cA, voffA); PG8_STAGE(PG8_SA(0, 1), cA + hstep, voffA);
        if (wr == 1) PG8_BAR;
        PG8_WAIT_V(2); PG8_BAR;
        PG8_STAGE(PG8_SB(1, 0), cB + kstep, voffB); PG8_STAGE(PG8_SA(1, 0), cA + kstep, voffA); PG8_STAGE(PG8_SB(1, 1), cB + hstep + kstep, voffB);
        PG8_WAIT_V(6); PG8_BAR;
    } else {
        PG8_STAGE(PG8_SB(0, 0), cB, voffB); PG8_STAGE(PG8_SA(0, 0), cA, voffA); PG8_STAGE(PG8_SB(0, 1), cB + hstep, voffB); PG8_STAGE(PG8_SA(0, 1), cA + hstep, voffA);
        if (wr == 1) PG8_BAR;
        PG8_WAIT_V(4); PG8_BAR;
        PG8_STAGE(PG8_SB(1, 0), cB + kstep, voffB); PG8_STAGE(PG8_SA(1, 0), cA + kstep, voffA); PG8_STAGE(PG8_SB(1, 1), cB + hstep + kstep, voffB);
        PG8_WAIT_V(6); PG8_BAR;
    }
    for (;;) {
        const bool has_next = S.next(ui + 1, nxt);
        const char* nA = has_next ? (const char*)g.A + (size_t)nxt.pm * tstep : cA; const char* nB = has_next ? (const char*)g.Bt + (size_t)nxt.pn * tstep : cB;
        for (int t = 0; t < nt; t += 2) {
            const bool last = (t == nt - 2);
            const char* a1 = cA + (size_t)(t + 1) * kstep;
            const char* a2 = last ? nA : cA + (size_t)(t + 2) * kstep; const char* b2 = last ? nB : cB + (size_t)(t + 2) * kstep;
            const char* a3 = a2 + kstep; const char* b3 = b2 + kstep;
            if (last && has_next) S.a_ready(nxt);
            if constexpr (SP2) {
            PG8_LDB(B0, 0, 0); PG8_LDB(B1, 0, 1); PG8_SCHED; PG8_LDA(At, 0, 0); PG8_STAGE(PG8_SA(1, 1), a1 + hstep, voffA);
            PG8_WAIT_V(8); PG8_WAIT_L(0); PG8_BAR; PG8_MMA(0, 0, At, B0); PG8_MMA(0, 1, At, B1); PG8_BAR; PG8_SCHED;
            PG8_LDA(At, 0, 1); PG8_STAGE(PG8_SB(0, 0), b2, voffB); PG8_STAGE(PG8_SB(0, 1), b2 + hstep, voffB); PG8_STAGE(PG8_SA(0, 0), a2, voffA);
            PG8_WAIT_V(8); PG8_WAIT_L(0); PG8_BAR; PG8_MMA(1, 0, At, B0); PG8_MMA(1, 1, At, B1); PG8_BAR; PG8_SCHED;
            PG8_LDB(B0, 1, 0); PG8_LDB(B1, 1, 1); PG8_SCHED; PG8_LDA(At, 1, 0); PG8_STAGE(PG8_SA(0, 1), a2 + hstep, voffA);
            PG8_WAIT_V(8); PG8_WAIT_L(0); PG8_BAR; PG8_MMA(0, 0, At, B0); PG8_MMA(0, 1, At, B1); PG8_BAR; PG8_SCHED;
            PG8_LDA(At, 1, 1); PG8_STAGE(PG8_SB(1, 0), b3, voffB); PG8_STAGE(PG8_SB(1, 1), b3 + hstep, voffB); PG8_STAGE(PG8_SA(1, 0), a3, voffA);
            PG8_WAIT_V(8); PG8_WAIT_L(0); PG8_BAR; PG8_MMA(1, 0, At, B0); PG8_MMA(1, 1, At, B1); PG8_BAR; PG8_SCHED;
            } else {
            PG8_LDB(B0, 0, 0); PG8_SCHED; PG8_LDA(At, 0, 0); PG8_STAGE(PG8_SA(1, 1), a1 + hstep, voffA);
            PG8_WAIT_L(8); PG8_BAR; PG8_WAIT_L(0); PG8_MMA(0, 0, At, B0); PG8_BAR; PG8_SCHED;
            PG8_LDB(B1, 0, 1); PG8_STAGE(PG8_SB(0, 0), b2, voffB);
            PG8_BAR; PG8_WAIT_L(0); PG8_MMA(0, 1, At, B1); PG8_BAR;
            PG8_LDA(At, 0, 1); PG8_STAGE(PG8_SA(0, 0), a2, voffA);
            PG8_BAR; PG8_WAIT_L(0); PG8_MMA(1, 0, At, B0); PG8_BAR; PG8_SCHED;
            PG8_STAGE(PG8_SB(0, 1), b2 + hstep, voffB);
            PG8_WAIT_V(6); PG8_BAR; PG8_MMA(1, 1, At, B1); PG8_BAR;
            PG8_LDB(B0, 1, 0); PG8_SCHED; PG8_LDA(At, 1, 0); PG8_STAGE(PG8_SA(0, 1), a2 + hstep, voffA);
            PG8_WAIT_L(8); PG8_BAR; PG8_WAIT_L(0); PG8_MMA(0, 0, At, B0); PG8_BAR; PG8_SCHED;
            PG8_LDB(B1, 1, 1); PG8_STAGE(PG8_SB(1, 0), b3, voffB);
            PG8_BAR; PG8_WAIT_L(0); PG8_MMA(0, 1, At, B1); PG8_BAR;
            PG8_LDA(At, 1, 1); PG8_STAGE(PG8_SA(1, 0), a3, voffA);
            PG8_BAR; PG8_WAIT_L(0); PG8_MMA(1, 0, At, B0); PG8_BAR; PG8_SCHED;
            PG8_STAGE(PG8_SB(1, 1), b3 + hstep, voffB);
            PG8_WAIT_V(6); PG8_BAR; PG8_MMA(1, 1, At, B1); PG8_BAR;
            }
        }
        if constexpr (ALIGN_EPI) { if (wr == 0) PG8_BAR; }
        if constexpr (!Epi::AFTER_DRAIN) { E(acc, cur, wr, wc, fr, fq); S.done(cur); }
        if (!has_next) break;
#pragma unroll
        for (int a = 0; a < 2; ++a)
#pragma unroll
            for (int b = 0; b < 2; ++b)
#pragma unroll
                for (int m = 0; m < 4; ++m)
#pragma unroll
                    for (int n = 0; n < 2; ++n) acc[a][b][m][n] = (f32x4){0.f, 0.f, 0.f, 0.f};
        cur = nxt; cA = nA; cB = nB; ++ui;
        if constexpr (ALIGN_EPI) { if (wr == 1) PG8_BAR; }
    }
    PG8_WAIT_V(0);
    if constexpr (!ALIGN_EPI) { if (wr == 0) PG8_BAR; }
    PG8_BAR;
    if constexpr (Epi::AFTER_DRAIN) { E.fused(acc, cur, wr, wc, fr, fq, lds, wid, lane); S.done(cur); }
#undef PG8_SA
#undef PG8_SB
#undef PG8_STAGE
#undef PG8_LDA
#undef PG8_LDB
#undef PG8_MMA
#undef PG8_WAIT_V
#undef PG8_WAIT_L
#undef PG8_BAR
#undef PG8_SCHED
}
}

constexpr int NWAVES = 8;
constexpr int BATCH = 8, SEQ = 2048, DEC_BATCH = 128, DEC_SEQ = 4, D = 1024, NPROJ = 4096, DEPTH = 4, NHEAD = 8, HD = 128;
constexpr int MP = BATCH * SEQ;
constexpr int MS = DEC_BATCH * DEC_SEQ;
constexpr int M = MP + MS;
constexpr float RMS_EPS = 1e-6f;
constexpr size_t OUT_Y = 0;
constexpr size_t OUT_CONVP = (size_t)M * D;
constexpr size_t OUT_CONVS = OUT_CONVP + 2 * 8 * 2 * 1024;
constexpr size_t OUT_HP = OUT_CONVS + 2 * 128 * 2 * 1024;
constexpr size_t OUT_HS = OUT_HP + (size_t)2 * 8 * 8 * 128 * 128;
constexpr size_t OUT_END = OUT_HS + (size_t)2 * 128 * 8 * 128 * 128;
constexpr size_t MiB = 1u << 20;
constexpr size_t WS_CTL = 0, CTL_ZERO_BYTES = 1 * MiB;
constexpr size_t WS_MISC = 1 * MiB;
constexpr size_t WS_WIN = 2 * MiB;
constexpr size_t WS_WOUT = 34 * MiB;
constexpr size_t ACT = 33 * MiB;
constexpr size_t WS_XB = 42 * MiB;
constexpr size_t WS_A0 = WS_XB + ACT, WS_A1 = WS_A0 + ACT, WS_A2 = WS_A1 + ACT, WS_A3 = WS_A2 + ACT, WS_A4 = WS_A3 + ACT, WS_A5 = WS_A4 + ACT;
constexpr size_t WS_F0 = WS_A5 + ACT;
constexpr size_t WS_Y = WS_F0 + 2 * ACT;
constexpr size_t WS_END = WS_Y + 2 * ACT;
static_assert((size_t)M * D * 2 <= ACT && WS_END <= 512 * MiB, "d_ws map");
constexpr int CW_BAR = 4096;
constexpr int RING_OFF = 0, RING_BYTES = 131072;
constexpr int LDSCTL_OFF = RING_BYTES, MISC_OFF = LDSCTL_OFF + 320;
constexpr int LDS_BYTES = 147456;

#define GAS __attribute__((address_space(1)))
#define LAS __attribute__((address_space(3)))
typedef unsigned short bf16;
typedef unsigned v4u __attribute__((ext_vector_type(4)));
typedef unsigned v2u __attribute__((ext_vector_type(2)));
typedef float f32x4 __attribute__((ext_vector_type(4)));
typedef short bf16x8 __attribute__((ext_vector_type(8)));
typedef GAS unsigned gu32;
#define RLX_AGENT __ATOMIC_RELAXED, __HIP_MEMORY_SCOPE_AGENT
#define LDS_WAIT() asm volatile("s_waitcnt lgkmcnt(0)" ::: "memory")
#define VM_WAIT() asm volatile("s_waitcnt vmcnt(0)" ::: "memory")
__device__ __forceinline__ unsigned f2bf(float f) { unsigned u = __builtin_bit_cast(unsigned, f); return (u + 0x7fffu + ((u >> 16) & 1u)) >> 16; }
__device__ __forceinline__ unsigned pk2(float lo, float hi) { return f2bf(lo) | (f2bf(hi) << 16); }
__device__ __forceinline__ float bflo(unsigned w) { return __builtin_bit_cast(float, w << 16); }
__device__ __forceinline__ float bfhi(unsigned w) { return __builtin_bit_cast(float, w & 0xffff0000u); }
__device__ __forceinline__ float bf1(bf16 h) { return __builtin_bit_cast(float, (unsigned)h << 16); }

#define XB_TMO      128
#define XB_XCNT(j)  (256  + 64 * (j))
#define XB_XSUB(j)  (1280 + 64 * (j))
#define XB_XGEN(j)  (2304 + 64 * (j))
#define XB_TOP      3328
#define XB_TOPGEN   3392
#define XCD_BAR_WORDS 3456
#define XB_SPIN_CAP (1u << 18)

__device__ __forceinline__ unsigned xb_ld(unsigned* p)              { return __hip_atomic_load(p, __ATOMIC_RELAXED, __HIP_MEMORY_SCOPE_AGENT); }
__device__ __forceinline__ unsigned xb_add(unsigned* p, unsigned v) { return __hip_atomic_fetch_add(p, v, __ATOMIC_RELAXED, __HIP_MEMORY_SCOPE_AGENT); }
__device__ __forceinline__ unsigned xb_xcc_id() { return (unsigned)__builtin_amdgcn_s_getreg((3 << 11) | 20) & 0xFu; }
#define XB_SPIN(cond, bar) do { unsigned _sp = 0; while (cond) { __builtin_amdgcn_s_sleep(1); \
    if ((++_sp & 255u) == 0u) { if (xb_ld(&(bar)[XB_TMO])) break; if (_sp > XB_SPIN_CAP) { atomicAdd(&(bar)[XB_TMO], 1u); break; } } } } while (0)

struct XcdBarrier {
    unsigned* bar; unsigned x;
    volatile LAS unsigned* st;
};

__device__ __forceinline__ XcdBarrier xcd_barrier_post(unsigned* bar, volatile LAS unsigned* st) {
    XcdBarrier b; b.bar = bar; b.x = xb_xcc_id(); b.st = st;
    if (threadIdx.x == 0) (void)xb_add(&bar[XB_XCNT(b.x)], 1u);
    return b;
}
__device__ __forceinline__ void xcd_barrier_complete(unsigned* bar, unsigned x, unsigned& nloc, unsigned& nx) {
    const unsigned G = gridDim.x * gridDim.y * gridDim.z;
    unsigned sum, cnt, mine, sp = 0u;
    for (;;) {
        sum = 0u; cnt = 0u; mine = 0u;
#pragma unroll
        for (unsigned j = 0; j < 16; ++j) { const unsigned c = xb_ld(&bar[XB_XCNT(j)]); sum += c; cnt += (c > 0u) ? 1u : 0u; mine = (j == x) ? c : mine; }
        if (sum == G) break;
        __builtin_amdgcn_s_sleep(1);
        if ((++sp & 255u) == 0u) { if (xb_ld(&bar[XB_TMO])) break; if (sp > XB_SPIN_CAP) { atomicAdd(&bar[XB_TMO], 1u); break; } }
    }
    nloc = mine > 0u ? mine : 1u; nx = cnt > 0u ? cnt : 1u;
}

__device__ __forceinline__ void xcd_barrier(const XcdBarrier& b) {
    asm volatile("s_waitcnt vmcnt(0)" ::: "memory");
    __syncthreads();
    if (threadIdx.x == 0) {
        unsigned* bar = b.bar;
        __builtin_amdgcn_s_waitcnt(0);
        unsigned nloc = b.st[0], nx = b.st[1];
        if (nloc == 0u) { xcd_barrier_complete(bar, b.x, nloc, nx); b.st[0] = nloc; b.st[1] = nx; }
        const unsigned old = xb_add(&bar[XB_XSUB(b.x)], 1u);
        const unsigned gen = old / nloc;
        if (old + 1u == (gen + 1u) * nloc) {
            __builtin_amdgcn_fence(__ATOMIC_RELEASE, "agent");
            asm volatile("s_waitcnt vmcnt(0)" ::: "memory");
            const unsigned og = xb_add(&bar[XB_TOP], 1u);
            const unsigned tg = og / nx;
            if (og + 1u == (tg + 1u) * nx) xb_add(&bar[XB_TOPGEN], 1u);
            else XB_SPIN(xb_ld(&bar[XB_TOPGEN]) == tg, bar);
            __builtin_amdgcn_fence(__ATOMIC_ACQUIRE, "agent");
            xb_add(&bar[XB_XGEN(b.x)], 1u);
            asm volatile("s_waitcnt vmcnt(0)" ::: "memory");
        } else {
            XB_SPIN(xb_ld(&bar[XB_XGEN(b.x)]) == gen, bar);
            __builtin_amdgcn_fence(__ATOMIC_ACQUIRE, "agent");
            asm volatile("s_waitcnt vmcnt(0)" ::: "memory");
        }
    }
    __syncthreads();
}


struct Frame {
    LAS unsigned char* lds;
    volatile LAS unsigned* MISC;
    gu32* ctl;
    int tid, lane, wave, vcu, G;
};
struct Ptrs {
    const float *x_prompt, *x_sample, *state_conv, *state_hgrn, *norm_pre, *w_in, *conv_w, *lb_logits, *onorm, *w_out, *norm_post;
    float* out; unsigned char* ws;
};
struct Args { Ptrs p; int pad0, pad1; };
typedef const __attribute__((address_space(4))) Args* KArgs;
#if defined(__HIP_DEVICE_COMPILE__)
__device__ __forceinline__ Ptrs kargs() { KArgs p = (KArgs)__builtin_amdgcn_kernarg_segment_ptr(); asm volatile("" : "+s"(p)); return p->p; }
#else
__device__ __forceinline__ Ptrs kargs() { return Ptrs{}; }
#endif
__device__ __forceinline__ int opaque_tid() { int t = threadIdx.x; asm volatile("" : "+v"(t)); return t; }
__device__ __forceinline__ float wave_sum(float v) {
#pragma unroll
    for (int o = 1; o < 64; o <<= 1) v += __shfl_xor(v, o);
    return v;
}
template <bool PERMIN>
__device__ __forceinline__ void p0_transpose_item(const float* W, const float* gain, int K, int N, bf16* WT, LAS float* scr, int item, int lane) {
    const int nblk = N / 32, kb = item / nblk, nb = item % nblk, k0 = 64 * kb, n0 = 32 * nb;
#pragma unroll 8
    for (int i = 0; i < 32; ++i) { const int kk = 2 * i + (lane >> 5); float w = W[(size_t)(k0 + kk) * N + n0 + (lane & 31)]; if (gain) w *= gain[k0 + kk]; scr[kk * 33 + (lane & 31)] = w; }
    LDS_WAIT(); asm volatile("" ::: "memory");
    const int c = lane & 7;
#pragma unroll
    for (int j = 0; j < 4; ++j) { const int n = (lane >> 3) + 8 * j; const LAS float* s = scr + (8 * c) * 33 + n;
        v4u o; o.x = pk2(s[0 * 33], s[1 * 33]); o.y = pk2(s[2 * 33], s[3 * 33]); o.z = pk2(s[4 * 33], s[5 * 33]); o.w = pk2(s[6 * 33], s[7 * 33]);
        const int drow = PERMIN ? pg8::inproj_row(n0 + n) : (n0 + n);
        *(GAS v4u*)(WT + (size_t)drow * K + k0 + 8 * c) = o; }
    LDS_WAIT(); asm volatile("" ::: "memory");
}
struct RowRegs { f32x4 v[4]; };
__device__ __forceinline__ RowRegs row_load(const float* p, int lane) { RowRegs r; const GAS f32x4* q = (const GAS f32x4*)p + lane;
#pragma unroll
    for (int j = 0; j < 4; ++j) r.v[j] = q[64 * j]; return r; }
__device__ __forceinline__ float row_ssq(const RowRegs& r) { float s = 0.f;
#pragma unroll
    for (int j = 0; j < 4; ++j) s += (r.v[j].x * r.v[j].x + r.v[j].y * r.v[j].y) + (r.v[j].z * r.v[j].z + r.v[j].w * r.v[j].w); return wave_sum(s); }
__device__ __forceinline__ void row_store_f32(float* p, const RowRegs& r, int lane) { GAS f32x4* q = (GAS f32x4*)p + lane;
#pragma unroll
    for (int j = 0; j < 4; ++j) q[64 * j] = r.v[j]; }
__device__ __forceinline__ void row_store_bf16(bf16* p, const RowRegs& r, int lane) { GAS v2u* q = (GAS v2u*)p + lane;
#pragma unroll
    for (int j = 0; j < 4; ++j) { v2u w; w.x = pk2(r.v[j].x, r.v[j].y); w.y = pk2(r.v[j].z, r.v[j].w); q[64 * j] = w; } }


__device__ __forceinline__ void p0_prologue(Frame& F) {
    const Ptrs A = kargs();
    const int tid = opaque_tid(), lane = tid & 63, wave = __builtin_amdgcn_readfirstlane(tid >> 6);
    LAS float* scr = (LAS float*)(F.lds + RING_OFF + wave * 16384);
    const int gw = F.vcu * NWAVES + wave, NGW = F.G * NWAVES;
    constexpr int I_IN = (D / 64) * (NPROJ / 32), I_OUT = (D / 64) * (D / 32);
    constexpr int NITEMS = DEPTH * (I_IN + I_OUT);
    for (int it = gw; it < NITEMS; it += NGW) {
        const int l = it / (I_IN + I_OUT), r = it % (I_IN + I_OUT);
        if (r < I_IN) p0_transpose_item<true>(A.w_in + (size_t)l * D * NPROJ, A.norm_pre + l * D, D, NPROJ, (bf16*)(A.ws + WS_WIN) + (size_t)l * NPROJ * D, scr, r, lane);
        else p0_transpose_item<false>(A.w_out + (size_t)l * D * D, nullptr, D, D, (bf16*)(A.ws + WS_WOUT) + (size_t)l * D * D, scr, r - I_IN, lane);
    }
    float* rstd = (float*)(A.ws + WS_MISC + 65536); bf16* XB = (bf16*)(A.ws + WS_XB);
    for (int m = gw; m < M; m += NGW) {
        const float* src = m < MP ? A.x_prompt + (size_t)m * D : A.x_sample + (size_t)(m - MP) * D;
        RowRegs r = row_load(src, lane);
        const float ss = row_ssq(r);
        row_store_f32(A.out + OUT_Y + (size_t)m * D, r, lane); row_store_bf16(XB + (size_t)m * D, r, lane);
        if (lane == 0) rstd[m] = 1.0f / sqrtf(ss * (1.0f / D) + RMS_EPS);
    }
    if (blockIdx.x == 0) {
        float* LB = (float*)(A.ws + WS_MISC);
        for (int c = tid; c < D; c += NWAVES * 64) { const float l0 = A.lb_logits[c], l1 = A.lb_logits[D + c]; LB[c] = 0.f; LB[D + c] = 1.0f / (1.0f + __expf(l0 - l1)); }
    }
}
__device__ __forceinline__ void post_phase(Frame& F, int layer) {
    const Ptrs A = kargs();
    const int tid = opaque_tid(), lane = tid & 63, wave = __builtin_amdgcn_readfirstlane(tid >> 6);
    const int gw = F.vcu * NWAVES + wave, NGW = F.G * NWAVES;
    float* rstd = (float*)(A.ws + WS_MISC + 65536); bf16* XB = (bf16*)(A.ws + WS_XB); const float* Y = (const float*)(A.ws + WS_Y);
    const RowRegs g = row_load(A.norm_post + layer * D, lane);
    for (int m = gw; m < M; m += NGW) {
        RowRegs y = row_load(Y + (size_t)m * D, lane); RowRegs x = row_load(A.out + OUT_Y + (size_t)m * D, lane);
        const float ry = 1.0f / sqrtf(row_ssq(y) * (1.0f / D) + RMS_EPS);
#pragma unroll
        for (int j = 0; j < 4; ++j) x.v[j] = x.v[j] + (y.v[j] * ry) * g.v[j];
        const float ss = row_ssq(x);
        row_store_f32(A.out + OUT_Y + (size_t)m * D, x, lane);
        if (layer < DEPTH - 1) { row_store_bf16(XB + (size_t)m * D, x, lane); if (lane == 0) rstd[m] = 1.0f / sqrtf(ss * (1.0f / D) + RMS_EPS); }
    }
}
struct Row16 { v4u a, b; };
__device__ __forceinline__ Row16 ld16(const bf16* p) { Row16 r; r.a = *(const GAS v4u*)p; r.b = *(const GAS v4u*)(p + 8); return r; }
__device__ __forceinline__ void unpack16(const Row16& r, float (&f)[16]) {
    f[0] = bflo(r.a.x); f[1] = bfhi(r.a.x); f[2] = bflo(r.a.y); f[3] = bfhi(r.a.y); f[4] = bflo(r.a.z); f[5] = bfhi(r.a.z); f[6] = bflo(r.a.w); f[7] = bfhi(r.a.w);
    f[8] = bflo(r.b.x); f[9] = bfhi(r.b.x); f[10] = bflo(r.b.y); f[11] = bfhi(r.b.y); f[12] = bflo(r.b.z); f[13] = bfhi(r.b.z); f[14] = bflo(r.b.w); f[15] = bfhi(r.b.w); }
__device__ __forceinline__ void st16(bf16* p, const float (&f)[16]) {
    v4u a, b; a.x = pk2(f[0], f[1]); a.y = pk2(f[2], f[3]); a.z = pk2(f[4], f[5]); a.w = pk2(f[6], f[7]); b.x = pk2(f[8], f[9]); b.y = pk2(f[10], f[11]); b.z = pk2(f[12], f[13]); b.w = pk2(f[14], f[15]);
    *(GAS v4u*)p = a; *(GAS v4u*)(p + 8) = b; }
__device__ __forceinline__ void ldf16(const float* p, float (&f)[16]) {
#pragma unroll
    for (int i = 0; i < 4; ++i) { const f32x4 v = *(const GAS f32x4*)(p + 4 * i); f[4 * i] = v.x; f[4 * i + 1] = v.y; f[4 * i + 2] = v.z; f[4 * i + 3] = v.w; } }
__device__ __forceinline__ void conv_prep_phase(Frame& F, int jl) {
    const Ptrs A = kargs();
    const int tid = opaque_tid(), lane = tid & 63, wave = __builtin_amdgcn_readfirstlane(tid >> 6);
    const int gw = F.vcu * NWAVES + wave, NGW = F.G * NWAVES;
    const bf16* U = (const bf16*)(A.ws + WS_A0); const bf16* P = (const bf16*)(A.ws + WS_A1); bf16* G = (bf16*)(A.ws + WS_A2);
    const int c0 = 16 * lane;
    float w0[16], w1[16], w2[16];
    ldf16(A.conv_w + (size_t)(jl * 3 + 0) * D + c0, w0); ldf16(A.conv_w + (size_t)(jl * 3 + 1) * D + c0, w1); ldf16(A.conv_w + (size_t)(jl * 3 + 2) * D + c0, w2);
    for (int m = gw; m < M; m += NGW) {
        float u0[16], um1[16], um2[16], p[16], o[16];
        unpack16(ld16(U + (size_t)m * D + c0), u0); unpack16(ld16(P + (size_t)m * D + c0), p);
        int t; const float* st = nullptr;
        if (m < MP) t = m & (SEQ - 1); else { const int rs = m - MP; t = rs & 3; st = A.state_conv + ((size_t)(jl * DEC_BATCH + (rs >> 2)) * 2) * D + c0; }
        if (t >= 1) unpack16(ld16(U + (size_t)(m - 1) * D + c0), um1);
        else if (st) ldf16(st + D, um1);
        else {
#pragma unroll
            for (int i = 0; i < 16; ++i) um1[i] = 0.f; }
        if (t >= 2) unpack16(ld16(U + (size_t)(m - 2) * D + c0), um2);
        else if (st) ldf16(st + (t == 1 ? D : 0), um2);
        else {
#pragma unroll
            for (int i = 0; i < 16; ++i) um2[i] = 0.f; }
#pragma unroll
        for (int i = 0; i < 16; ++i) o[i] = p[i] * (w0[i] * um2[i] + w1[i] * um1[i] + w2[i] * u0[i]);
        st16(G + (size_t)m * D + c0, o);
    }
}
__device__ __forceinline__ void hgrn_prep_phase(Frame& F, int jl) {
    const Ptrs A = kargs();
    const int tid = opaque_tid(), lane = tid & 63, wave = __builtin_amdgcn_readfirstlane(tid >> 6);
    const int gw = F.vcu * NWAVES + wave, NGW = F.G * NWAVES;
    const bf16* O = (const bf16*)(A.ws + WS_A5); const bf16* SZ = (const bf16*)(A.ws + WS_A4); bf16* G = (bf16*)(A.ws + WS_A2);
    const int c0 = 16 * lane;
    float gn[16]; ldf16(A.onorm + (size_t)jl * HD + (c0 & (HD - 1)), gn);
    for (int m = gw; m < MP; m += NGW) {
        float o[16], z[16], g[16];
        unpack16(ld16(O + (size_t)m * D + c0), o); unpack16(ld16(SZ + (size_t)m * D + c0), z);
        float s = 0.f;
#pragma unroll
        for (int i = 0; i < 16; ++i) s += o[i] * o[i];
        s += __shfl_xor(s, 1); s += __shfl_xor(s, 2); s += __shfl_xor(s, 4);
        const float rs = 1.0f / sqrtf(s * (1.0f / HD) + RMS_EPS);
#pragma unroll
        for (int i = 0; i < 16; ++i) g[i] = o[i] * rs * gn[i] * z[i];
        st16(G + (size_t)m * D + c0, g);
    }
}
constexpr int RQ_RS = 136, RV_RS = 40;
constexpr int RB_QT = 0, RB_KT = 17408, RB_VS = 34816, RB_SIZE = 39936, R2_SPT = 2 * RB_SIZE, R2_END = R2_SPT + 2 * 8704;
static_assert(R2_END <= RING_BYTES, "recurrence LDS map");
typedef short s16x4 __attribute__((ext_vector_type(4)));
#define REC_BAR() do { asm volatile("s_waitcnt lgkmcnt(0)" ::: "memory"); __builtin_amdgcn_s_barrier(); asm volatile("" ::: "memory"); } while (0)
#ifndef USE_TR
#define USE_TR 1
#endif
#if USE_TR
__device__ __forceinline__ s16x4 tr_read_issue(unsigned addr, int rs_bytes) { s16x4 r; asm volatile("ds_read_b64_tr_b16 %0, %1" : "=&v"(r) : "v"(addr) : "memory"); return r; }
#else
__device__ __forceinline__ s16x4 tr_read_issue(unsigned addr, int rs_bytes) { const int lane = threadIdx.x & 63, i = lane & 15, q = i >> 2, p = i & 3;
    const unsigned a0 = addr - q * rs_bytes - 8 * p + 2 * i; s16x4 r;
#pragma unroll
    for (int e = 0; e < 4; ++e) r[e] = *(const LAS short*)(size_t)(a0 + e * rs_bytes);
    return r; }
#endif
__device__ __forceinline__ bf16x8 cat8(s16x4 a, s16x4 b) { return __builtin_shufflevector(a, b, 0, 1, 2, 3, 4, 5, 6, 7); }

__device__ __forceinline__ void hgrn_prompt_phase(Frame& F, int jl) {
    const Ptrs A = kargs();
    const bf16* Q = (const bf16*)(A.ws + WS_A0); const bf16* KK = (const bf16*)(A.ws + WS_A1); const bf16* V = (const bf16*)(A.ws + WS_A3);
    const float* DV = (const float*)(A.ws + WS_F0); bf16* O = (bf16*)(A.ws + WS_A5);
    LAS unsigned char* L = F.lds + RING_OFF;
    const unsigned Lb = (unsigned)(size_t)L;
    const int tid = opaque_tid(), w = __builtin_amdgcn_readfirstlane(tid >> 6), lane = tid & 63, fr = lane & 15, fq = lane >> 4;
    const int tb = (0x1320 >> (4 * (w >> 1))) & 3, nv = w & 1;
    const int lt = tid >> 3, lc = (tid & 7) * 16, lv4 = (tid & 7) * 4;
    const int tq = (lane & 15) >> 2, tp = lane & 3;
    for (int item = blockIdx.x; item < BATCH * NHEAD * 4; item += F.G) {
        const int b = item >> 5, h = (item >> 2) & 7, vs = item & 3;
        const size_t base = (size_t)b * SEQ * D + h * HD;
        f32x4 S[2]; S[0] = (f32x4){0.f, 0.f, 0.f, 0.f}; S[1] = S[0];
        v4u rq[2], rk[2]; v2u rv;
        { const size_t o = base + (size_t)lt * D + lc;
          rq[0] = *(const GAS v4u*)(Q + o); rq[1] = *(const GAS v4u*)(Q + o + 8); rk[0] = *(const GAS v4u*)(KK + o); rk[1] = *(const GAS v4u*)(KK + o + 8);
          rv = *(const GAS v2u*)(V + base + (size_t)lt * D + vs * 32 + lv4); }
        *(LAS v4u*)(L + RB_QT + (lt * RQ_RS + lc) * 2) = rq[0]; *(LAS v4u*)(L + RB_QT + (lt * RQ_RS + lc + 8) * 2) = rq[1];
        *(LAS v4u*)(L + RB_KT + (lt * RQ_RS + lc) * 2) = rk[0]; *(LAS v4u*)(L + RB_KT + (lt * RQ_RS + lc + 8) * 2) = rk[1];
        *(LAS v2u*)(L + RB_VS + (lt * RV_RS + lv4) * 2) = rv;
#pragma unroll
        for (int n2 = 0; n2 < 2; ++n2) *(LAS v2u*)(L + R2_SPT + ((16 * n2 + fr) * RQ_RS + 16 * w + 4 * fq) * 2) = (v2u){0u, 0u};
        for (int c = 0; c < SEQ / 64; ++c) {
            REC_BAR();
            const int bo = (c & 1) * RB_SIZE, bn = RB_SIZE - bo, so = R2_SPT + (c & 1) * 8704, sn = R2_SPT + 8704 - (c & 1) * 8704;
            const size_t rowc = base + (size_t)(c * 64) * D;
            const bool more = c + 1 < SEQ / 64;
            if (more) { const size_t o = rowc + (size_t)(64 + lt) * D + lc;
                rq[0] = *(const GAS v4u*)(Q + o); rq[1] = *(const GAS v4u*)(Q + o + 8); rk[0] = *(const GAS v4u*)(KK + o); rk[1] = *(const GAS v4u*)(KK + o + 8);
                rv = *(const GAS v2u*)(V + rowc + (size_t)(64 + lt) * D + vs * 32 + lv4); }
            const int chunk = b * (SEQ / 64) + c, kch = h * HD + 16 * w + 4 * fq;
            const f32x4 d1 = *(const GAS f32x4*)(DV + (size_t)(256 + chunk) * D + kch), d2 = *(const GAS f32x4*)(DV + (size_t)(512 + chunk) * D + kch);
            f32x4 ern = (f32x4){0.f, 0.f, 0.f, 0.f}; if (more) ern = *(const GAS f32x4*)(DV + (size_t)(chunk + 1) * D + kch);
            bf16x8 qf[4];
#pragma unroll
            for (int kk = 0; kk < 4; ++kk) qf[kk] = *(const LAS bf16x8*)(L + bo + RB_QT + ((16 * tb + fr) * RQ_RS + 32 * kk + 8 * fq) * 2);
            f32x4 dt[4];
#pragma unroll
            for (int sb = 0; sb < 4; ++sb) { dt[sb] = (f32x4){0.f, 0.f, 0.f, 0.f};
                if (sb <= tb) {
#pragma unroll
                    for (int kk = 0; kk < 4; ++kk) { const bf16x8 kf = *(const LAS bf16x8*)(L + bo + RB_KT + ((16 * sb + fr) * RQ_RS + 32 * kk + 8 * fq) * 2);
                        dt[sb] = __builtin_amdgcn_mfma_f32_16x16x32_bf16(kf, qf[kk], dt[sb], 0, 0, 0); }
                    if (sb == tb) {
#pragma unroll
                        for (int rg = 0; rg < 4; ++rg) if (4 * fq + rg > fr) dt[sb][rg] = 0.f; } } }
            f32x4 oacc = (f32x4){0.f, 0.f, 0.f, 0.f};
#pragma unroll
            for (int k2 = 0; k2 < 2; ++k2) if (2 * k2 <= tb) {
                const unsigned a0 = Lb + bo + RB_VS + ((32 * k2 + 4 * fq + tq) * RV_RS + 16 * nv + 4 * tp) * 2;
                const s16x4 v0 = tr_read_issue(a0, RV_RS * 2), v1 = tr_read_issue(a0 + 16 * RV_RS * 2, RV_RS * 2);
                s16x4 v0w = v0, v1w = v1; asm volatile("s_waitcnt lgkmcnt(0)" : "+v"(v0w), "+v"(v1w) :: "memory"); __builtin_amdgcn_sched_barrier(0);
                v4u pb; pb.x = pg8::pkc(dt[2 * k2][0], dt[2 * k2][1]); pb.y = pg8::pkc(dt[2 * k2][2], dt[2 * k2][3]); pb.z = pg8::pkc(dt[2 * k2 + 1][0], dt[2 * k2 + 1][1]); pb.w = pg8::pkc(dt[2 * k2 + 1][2], dt[2 * k2 + 1][3]);
                oacc = __builtin_amdgcn_mfma_f32_16x16x32_bf16(cat8(v0w, v1w), __builtin_bit_cast(bf16x8, pb), oacc, 0, 0, 0); }
#pragma unroll
            for (int kk = 0; kk < 4; ++kk) { const bf16x8 sf = *(const LAS bf16x8*)(L + so + ((16 * nv + fr) * RQ_RS + 32 * kk + 8 * fq) * 2);
                oacc = __builtin_amdgcn_mfma_f32_16x16x32_bf16(sf, qf[kk], oacc, 0, 0, 0); }
            { v2u ow; ow.x = pg8::pkc(oacc[0], oacc[1]); ow.y = pg8::pkc(oacc[2], oacc[3]);
              *(GAS v2u*)(O + rowc + (size_t)(16 * tb + fr) * D + vs * 32 + 16 * nv + 4 * fq) = ow; }
            { s16x4 ka[2][2], va[2][2][2];
#pragma unroll
              for (int kk = 0; kk < 2; ++kk) { const unsigned ak = Lb + bo + RB_KT + ((32 * kk + 8 * fq + tq) * RQ_RS + 16 * w + 4 * tp) * 2;
                  ka[kk][0] = tr_read_issue(ak, RQ_RS * 2); ka[kk][1] = tr_read_issue(ak + 4 * RQ_RS * 2, RQ_RS * 2);
#pragma unroll
                  for (int n2 = 0; n2 < 2; ++n2) { const unsigned av = Lb + bo + RB_VS + ((32 * kk + 8 * fq + tq) * RV_RS + 16 * n2 + 4 * tp) * 2;
                      va[kk][n2][0] = tr_read_issue(av, RV_RS * 2); va[kk][n2][1] = tr_read_issue(av + 4 * RV_RS * 2, RV_RS * 2); } }
              asm volatile("s_waitcnt lgkmcnt(0)" : "+v"(ka[0][0]), "+v"(ka[0][1]), "+v"(ka[1][0]), "+v"(ka[1][1]), "+v"(va[0][0][0]), "+v"(va[0][0][1]), "+v"(va[0][1][0]), "+v"(va[0][1][1]),
                           "+v"(va[1][0][0]), "+v"(va[1][0][1]), "+v"(va[1][1][0]), "+v"(va[1][1][1]) :: "memory"); __builtin_amdgcn_sched_barrier(0);
#pragma unroll
              for (int n2 = 0; n2 < 2; ++n2) { f32x4 acc = (f32x4){0.f, 0.f, 0.f, 0.f};
#pragma unroll
                  for (int kk = 0; kk < 2; ++kk) acc = __builtin_amdgcn_mfma_f32_16x16x32_bf16(cat8(ka[kk][0], ka[kk][1]), cat8(va[kk][n2][0], va[kk][n2][1]), acc, 0, 0, 0);
                  S[n2] = d1 * S[n2] + d2 * acc;
                  const f32x4 sp = S[n2] * ern; v2u sw; sw.x = pg8::pkc(sp[0], sp[1]); sw.y = pg8::pkc(sp[2], sp[3]);
                  *(LAS v2u*)(L + sn + ((16 * n2 + fr) * RQ_RS + 16 * w + 4 * fq) * 2) = sw; } }
            if (more) {
                *(LAS v4u*)(L + bn + RB_QT + (lt * RQ_RS + lc) * 2) = rq[0]; *(LAS v4u*)(L + bn + RB_QT + (lt * RQ_RS + lc + 8) * 2) = rq[1];
                *(LAS v4u*)(L + bn + RB_KT + (lt * RQ_RS + lc) * 2) = rk[0]; *(LAS v4u*)(L + bn + RB_KT + (lt * RQ_RS + lc + 8) * 2) = rk[1];
                *(LAS v2u*)(L + bn + RB_VS + (lt * RV_RS + lv4) * 2) = rv; }
        }
        { float* HP = A.out + OUT_HP + ((size_t)((jl * BATCH + b) * NHEAD + h) * HD) * HD;
#pragma unroll
          for (int n2 = 0; n2 < 2; ++n2)
#pragma unroll
              for (int rg = 0; rg < 4; ++rg) HP[(size_t)(16 * w + 4 * fq + rg) * HD + vs * 32 + 16 * n2 + fr] = S[n2][rg]; }
        REC_BAR();
    }
}
__device__ __forceinline__ void hgrn_sample_phase(Frame& F, int jl) {
    const Ptrs A = kargs();
    const bf16* Q = (const bf16*)(A.ws + WS_A0); const bf16* KK = (const bf16*)(A.ws + WS_A1); const bf16* V = (const bf16*)(A.ws + WS_A3); const bf16* SZ = (const bf16*)(A.ws + WS_A4);
    const float* LOGF = (const float*)(A.ws + WS_F0); bf16* G = (bf16*)(A.ws + WS_A2);
    LAS float* L = (LAS float*)(F.lds + RING_OFF);
    LAS float* vq = L, *vk = L + 512, *vf = L + 1024, *vv = L + 1536, *vz = L + 2048, *red = L + 2560  , *ssw = L + 2560 + 8192  ;
    const int tid = opaque_tid(), lane = tid & 63, wave = __builtin_amdgcn_readfirstlane(tid >> 6);
    for (int it = blockIdx.x; it < DEC_BATCH * NHEAD; it += F.G) {
        const int b = it >> 3, h = it & 7; const size_t rbase = (size_t)(MP + 4 * b) * D + h * HD;
        const int v0 = 4 * (tid & 31), k0 = 8 * (tid >> 5);
        const float* S0 = A.state_hgrn + ((size_t)((jl * DEC_BATCH + b) * NHEAD + h) * HD) * HD;
        f32x4 S[8];
#pragma unroll
        for (int i = 0; i < 8; ++i) S[i] = *(const GAS f32x4*)(S0 + (size_t)(k0 + i) * HD + v0);
        { const int t = tid >> 7, k = tid & 127; const size_t o = rbase + (size_t)t * D + k;
          vq[tid] = bf1(Q[o]); vk[tid] = bf1(KK[o]); vf[tid] = __expf(LOGF[o]); vv[tid] = bf1(V[o]); vz[tid] = bf1(SZ[o]); }
        __syncthreads();
        f32x4 op[4];
#pragma unroll
        for (int t = 0; t < 4; ++t) { op[t] = (f32x4){0.f, 0.f, 0.f, 0.f}; const f32x4 vt = *(const LAS f32x4*)(vv + t * 128 + v0);
#pragma unroll
            for (int i = 0; i < 8; ++i) { const float f = vf[t * 128 + k0 + i], kk = vk[t * 128 + k0 + i], qq = vq[t * 128 + k0 + i];
                S[i] = S[i] * f + vt * kk; op[t] = op[t] + S[i] * qq; } }
        float* S1 = A.out + OUT_HS + ((size_t)((jl * DEC_BATCH + b) * NHEAD + h) * HD) * HD;
#pragma unroll
        for (int i = 0; i < 8; ++i) *(GAS f32x4*)(S1 + (size_t)(k0 + i) * HD + v0) = S[i];
#pragma unroll
        for (int t = 0; t < 4; ++t) *(LAS f32x4*)(red + (t * 16 + (tid >> 5)) * 128 + v0) = op[t];
        __syncthreads();
        { const int t = tid >> 7, v = tid & 127; float o = 0.f;
#pragma unroll
          for (int kq = 0; kq < 16; ++kq) o += red[(t * 16 + kq) * 128 + v];
          const float ss = wave_sum(o * o);
          if (lane == 0) ssw[wave] = ss;
          __syncthreads();
          const float rs = 1.0f / sqrtf((ssw[2 * t] + ssw[2 * t + 1]) * (1.0f / HD) + RMS_EPS);
          G[rbase + (size_t)t * D + v] = (bf16)f2bf(o * rs * A.onorm[jl * HD + v] * vz[tid]); }
        __syncthreads();
    }
}
__global__ void __launch_bounds__(NWAVES * 64, 2) fwd_kernel(Args args) {
    extern __shared__ __attribute__((aligned(16))) unsigned char lds[];
    Frame F;
    F.lds = (LAS unsigned char*)lds;
    F.MISC = (volatile LAS unsigned*)(F.lds + MISC_OFF);
    F.tid = threadIdx.x; F.lane = F.tid & 63; F.wave = __builtin_amdgcn_readfirstlane(F.tid >> 6);
    F.G = gridDim.x; { const int bx = blockIdx.x; F.vcu = (F.G % 8 == 0) ? (bx % 8) * (F.G / 8) + bx / 8 : bx; }
    F.ctl = (gu32*)(kargs().ws + WS_CTL);
    for (int u = F.tid; u < (LDS_BYTES - LDSCTL_OFF) / 4; u += NWAVES * 64) ((LAS unsigned*)(F.lds + LDSCTL_OFF))[u] = 0u;
    __syncthreads();
    XcdBarrier bar = xcd_barrier_post((unsigned*)(F.ctl + CW_BAR), F.MISC + 8);
#define GRID_BAR() xcd_barrier(bar)

    p0_prologue(F);
    GRID_BAR();
    for (int layer = 0; layer < DEPTH; ++layer) {
        const int jl = layer >> 1;
        const Ptrs A = kargs(); unsigned char* ws = A.ws;
        const float* rstd = (const float*)(ws + WS_MISC + 65536); const float* LB = (const float*)(ws + WS_MISC); const bf16* XB = (const bf16*)(ws + WS_XB);
        const bf16* WinT = (const bf16*)(ws + WS_WIN) + (size_t)layer * NPROJ * D;
        const bf16* WoutT = (const bf16*)(ws + WS_WOUT) + (size_t)layer * D * D;
        if ((layer & 1) == 0) {
            { pg8::Gemm g{XB, WinT, M, NPROJ, D}; pg8::StaticOrder S; S.init(M, NPROJ, F.G, (int)blockIdx.x);
              pg8::EpiConvIn E{rstd, (bf16*)(ws + WS_A0), (bf16*)(ws + WS_A1), A.out + OUT_CONVP + (size_t)jl * 8 * 2 * D, A.out + OUT_CONVS + (size_t)jl * 128 * 2 * D};
              pg8::gemm_phase<pg8::EpiConvIn, pg8::StaticOrder, true, true>(F.lds + RING_OFF, g, S, E); }
            GRID_BAR();
            conv_prep_phase(F, jl);
            GRID_BAR();
        } else {
            { pg8::Gemm g{XB, WinT, M, NPROJ, D}; pg8::StaticOrder S; S.init(M, NPROJ, F.G, (int)blockIdx.x);
              pg8::EpiHgrnIn E{rstd, LB + jl * D, (bf16*)(ws + WS_A0), (bf16*)(ws + WS_A1), (bf16*)(ws + WS_A3), (bf16*)(ws + WS_A4), (float*)(ws + WS_F0), (float*)(ws + WS_F0)};
              pg8::gemm_phase<pg8::EpiHgrnIn, pg8::StaticOrder, true, true>(F.lds + RING_OFF, g, S, E); }
            GRID_BAR();
            hgrn_prompt_phase(F, jl);
            hgrn_sample_phase(F, jl);
            GRID_BAR();
            hgrn_prep_phase(F, jl);
            GRID_BAR();
        }
        { pg8::Gemm g{(const bf16*)(ws + WS_A2), WoutT, M, D, D}; pg8::StaticOrder S; S.init(M, D, F.G, (int)blockIdx.x);
          pg8::EpiF32 E{(float*)(ws + WS_Y)};
          pg8::gemm_phase<pg8::EpiF32, pg8::StaticOrder, true, true>(F.lds + RING_OFF, g, S, E); }
        GRID_BAR();
        post_phase(F, layer);
        if (layer + 1 < DEPTH) GRID_BAR();
    }
}

extern "C" void kernel_launch(void* const* d_in, const int* in_sizes, int n_in, void* d_out, int out_size, void* d_ws, size_t ws_size, hipStream_t stream) {
    static int grid = 0;
    if (grid == 0) {
        if (n_in != 11 || (size_t)out_size != OUT_END || ws_size < WS_END) { fprintf(stderr, "kernel_launch: unexpected shapes: n_in %d out %d ws %zu\n", n_in, out_size, ws_size); grid = -1; return; }
        int dev = 0, cus = 0, per_cu = 0;
        if (hipGetDevice(&dev) != hipSuccess || hipDeviceGetAttribute(&cus, hipDeviceAttributeMultiprocessorCount, dev) != hipSuccess) { grid = -1; return; }
        if (hipFuncSetAttribute((const void*)fwd_kernel, hipFuncAttributeMaxDynamicSharedMemorySize, LDS_BYTES) != hipSuccess) { fprintf(stderr, "kernel_launch: hipFuncSetAttribute failed\n"); grid = -1; return; }
        if (hipOccupancyMaxActiveBlocksPerMultiprocessor(&per_cu, (const void*)fwd_kernel, NWAVES * 64, LDS_BYTES) != hipSuccess || per_cu < 1)
            fprintf(stderr, "kernel_launch: note: occupancy query reports %d workgroups per CU\n", per_cu);
        (void)hipGetLastError();
        grid = cus;
    }
    if (grid < 0) return;
    if (hipMemsetAsync((char*)d_ws + WS_CTL, 0, CTL_ZERO_BYTES, stream) != hipSuccess) { fprintf(stderr, "kernel_launch: hipMemsetAsync failed\n"); return; }
    Args a{};
    a.p.x_prompt = (const float*)d_in[0]; a.p.x_sample = (const float*)d_in[1]; a.p.state_conv = (const float*)d_in[2]; a.p.state_hgrn = (const float*)d_in[3];
    a.p.norm_pre = (const float*)d_in[4]; a.p.w_in = (const float*)d_in[5]; a.p.conv_w = (const float*)d_in[6]; a.p.lb_logits = (const float*)d_in[7];
    a.p.onorm = (const float*)d_in[8]; a.p.w_out = (const float*)d_in[9]; a.p.norm_post = (const float*)d_in[10];
    a.p.out = (float*)d_out; a.p.ws = (unsigned char*)d_ws;
    hipLaunchKernelGGL(fwd_kernel, dim3(grid), dim3(NWAVES * 64), LDS_BYTES, stream, a);
    const hipError_t le = hipPeekAtLastError();
    if (le != hipSuccess) fprintf(stderr, "kernel_launch: launch failed: %s\n", hipGetErrorName(le));
}
```
